# Optimizing an MI355X kernel written in HIP

```python
import jax, jax.numpy as jnp
from jax import lax
import numpy as np

D_MODEL = 1024
BATCH = 4
SEQ = 8192
DEPTH = 1
DEC_BATCH = 128
DEC_SEQ = 1
PAST_LEN = 16384
PAGE_SIZE = 128

N_HEADS = 16
N_KV_HEADS = 4
HEAD_DIM = 64
GROUP = N_HEADS // N_KV_HEADS
WINDOW = 128
BLOCK = WINDOW
ROPE_THETA = 10000.0
C_CONV = D_MODEL
CONV_W = 31
D_FF = 4 * D_MODEL
D_PLE = 256
EPS = 1e-6
NEG = -1e30
Q_W = N_HEADS * HEAD_DIM
KV_W = N_KV_HEADS * HEAD_DIM
D_IN = Q_W + 2 * KV_W + 2 * C_CONV + 2 * D_MODEL

kernel_name = "hybrid_conformer_swa_sink_decoder_step"


def rmsnorm(x, g):
    xf = x.astype(jnp.float32)
    y = xf * lax.rsqrt(jnp.mean(xf * xf, axis=-1, keepdims=True) + EPS)
    return (y * g.astype(jnp.float32)).astype(x.dtype)


def layernorm(x, g, b):
    xf = x.astype(jnp.float32)
    mu = jnp.mean(xf, axis=-1, keepdims=True)
    var = jnp.mean(jnp.square(xf - mu), axis=-1, keepdims=True)
    y = (xf - mu) * lax.rsqrt(var + EPS) * g.astype(jnp.float32) + b.astype(jnp.float32)
    return y.astype(x.dtype)


def rope(x, pos):
    half = HEAD_DIM // 2
    inv = jnp.power(jnp.float32(ROPE_THETA), -jnp.arange(half, dtype=jnp.float32) / half)
    ang = pos.astype(jnp.float32)[:, None] * inv[None, :]
    cos = jnp.cos(ang)[None, :, None, :]
    sin = jnp.sin(ang)[None, :, None, :]
    xf = x.astype(jnp.float32)
    x1, x2 = xf[..., :half], xf[..., half:]
    return jnp.concatenate([x1 * cos - x2 * sin, x2 * cos + x1 * sin], axis=-1).astype(x.dtype)


def sink_attention(q, k, v, mask, sinks):
    s = jnp.einsum('bnqhgd,bnkhd->bnhgqk', q, k, preferred_element_type=jnp.float32) * (HEAD_DIM ** -0.5)
    s = jnp.where(mask[None, :, None, None], s, NEG)
    sk = sinks.astype(jnp.float32).reshape(N_KV_HEADS, GROUP)[None, None, :, :, None, None]
    m = jnp.maximum(jnp.max(s, axis=-1, keepdims=True), sk)
    e = jnp.exp(s - m)
    den = jnp.sum(e, axis=-1, keepdims=True) + jnp.exp(sk - m)
    pr = (e / den).astype(v.dtype)
    return jnp.einsum('bnhgqk,bnkhd->bnqhgd', pr, v)


def branch_inputs(x, pos, lp):
    B, T = x.shape[0], x.shape[1]
    u = rmsnorm(x, lp['ln1'])
    z = u @ lp['w_in']
    q, k, v, glu, gts = jnp.split(z, [Q_W, Q_W + KV_W, Q_W + 2 * KV_W, Q_W + 2 * KV_W + 2 * C_CONV], axis=-1)
    q = rope(rmsnorm(q.reshape(B, T, N_HEADS, HEAD_DIM), lp['q_norm']), pos)
    k = rope(rmsnorm(k.reshape(B, T, N_KV_HEADS, HEAD_DIM), lp['k_norm']), pos)
    v = v.reshape(B, T, N_KV_HEADS, HEAD_DIM)
    glu = glu + lp['b_glu']
    a = glu[..., :C_CONV] * jax.nn.sigmoid(glu[..., C_CONV:])
    return q, k, v, a, gts


def conv_branch(a_hist, lp):
    y = lax.conv_general_dilated(a_hist, lp['conv_dw'][:, None, :], (1,), 'VALID',
                                 dimension_numbers=('NWC', 'WIO', 'NWC'),
                                 feature_group_count=C_CONV) + lp['conv_dw_b']
    y = jax.nn.silu(layernorm(y, lp['conv_ln_g'], lp['conv_ln_b']))
    return y @ lp['w_conv_out'] + lp['b_conv_out']


def finish(x, attn_o, conv_o, gts, p, lp):
    g_attn, g_conv = jnp.split(gts, 2, axis=-1)
    mixed = jax.nn.sigmoid(g_attn) * (attn_o @ lp['w_o_attn']) + jax.nn.sigmoid(g_conv) * conv_o
    h = x + mixed @ lp['w_out']
    h = h + jnp.square(jax.nn.relu(rmsnorm(h, lp['ln2']) @ lp['w_ff1'])) @ lp['w_ff2']
    gate = jax.nn.sigmoid(rmsnorm(h, lp['ln_ple']) @ lp['w_ple_gate'])
    return h + gate * (p @ lp['w_ple'])


def prompt_layer(x, p, lp):
    B, S = x.shape[0], x.shape[1]
    pos = jnp.arange(S, dtype=jnp.int32)
    q, k, v, a, gts = branch_inputs(x, pos, lp)
    nb = S // BLOCK
    qb = q.reshape(B, nb, BLOCK, N_KV_HEADS, GROUP, HEAD_DIM)
    kb = k.reshape(B, nb, BLOCK, N_KV_HEADS, HEAD_DIM)
    vb = v.reshape(B, nb, BLOCK, N_KV_HEADS, HEAD_DIM)
    shift = ((0, 0), (1, 0), (0, 0), (0, 0), (0, 0))
    kc = jnp.concatenate([jnp.pad(kb[:, :-1], shift), kb], axis=2)
    vc = jnp.concatenate([jnp.pad(vb[:, :-1], shift), vb], axis=2)
    i = jnp.arange(BLOCK)[:, None]
    j = jnp.arange(2 * BLOCK)[None, :]
    rel = i - j + BLOCK
    band = (rel >= 0) & (rel < WINDOW)
    mask = band[None] & ((jnp.arange(nb)[:, None, None] > 0) | (j[None] >= BLOCK))
    attn_o = sink_attention(qb, kc, vc, mask, lp['sinks']).reshape(B, S, Q_W)
    a_hist = jnp.pad(a, ((0, 0), (CONV_W - 1, 0), (0, 0)))
    conv_o = conv_branch(a_hist, lp)
    y = finish(x, attn_o, conv_o, gts, p, lp)
    wb = min(WINDOW, S)
    return y, k[:, S - wb:], v[:, S - wb:], a[:, S - (CONV_W - 1):]


def sample_layer(x, p, ck, cv, cs, lp):
    Bd, T = x.shape[0], x.shape[1]
    wb = ck.shape[1]
    pos = PAST_LEN + jnp.arange(T, dtype=jnp.int32)
    q, k, v, a, gts = branch_inputs(x, pos, lp)
    kc = jnp.concatenate([ck.astype(k.dtype), k], axis=1)
    vc = jnp.concatenate([cv.astype(v.dtype), v], axis=1)
    kpos = PAST_LEN - wb + jnp.arange(wb + T, dtype=jnp.int32)
    rel = pos[:, None] - kpos[None, :]
    mask = ((rel >= 0) & (rel < WINDOW) & (kpos[None, :] >= 0))[None]
    qb = q.reshape(Bd, 1, T, N_KV_HEADS, GROUP, HEAD_DIM)
    attn_o = sink_attention(qb, kc[:, None], vc[:, None], mask, lp['sinks']).reshape(Bd, T, Q_W)
    a_hist = jnp.concatenate([cs.astype(a.dtype), a], axis=1)
    conv_o = conv_branch(a_hist, lp)
    y = finish(x, attn_o, conv_o, gts, p, lp)
    return y, kc[:, T:], vc[:, T:], a_hist[:, T:]


def setup_inputs(seed: int = 0) -> dict:
    key = jax.random.key(seed)
    ks = iter(jax.random.split(key, 40))
    f32 = jnp.float32

    def nrm(shape, scale):
        return jax.random.normal(next(ks), shape, f32) * scale

    L = DEPTH
    wb = min(WINDOW, PAST_LEN)
    return {
        "x_prompt": nrm((BATCH, SEQ, D_MODEL), 1.0),
        "x_sample": nrm((DEC_BATCH, DEC_SEQ, D_MODEL), 1.0),
        "cache_k": nrm((L, DEC_BATCH, wb, N_KV_HEADS, HEAD_DIM), 1.0),
        "cache_v": nrm((L, DEC_BATCH, wb, N_KV_HEADS, HEAD_DIM), 1.0),
        "state_conv": nrm((L, DEC_BATCH, CONV_W - 1, C_CONV), 0.5),
        "p_prompt": nrm((L, BATCH, SEQ, D_PLE), 1.0),
        "p_sample": nrm((L, DEC_BATCH, DEC_SEQ, D_PLE), 1.0),
        "ln1": 1.0 + nrm((L, D_MODEL), 0.02),
        "w_in": nrm((L, D_MODEL, D_IN), D_MODEL ** -0.5),
        "b_glu": nrm((L, 2 * C_CONV), 0.02),
        "q_norm": 1.0 + nrm((L, HEAD_DIM), 0.02),
        "k_norm": 1.0 + nrm((L, HEAD_DIM), 0.02),
        "sinks": nrm((L, N_HEADS), 0.5),
        "w_o_attn": nrm((L, Q_W, D_MODEL), Q_W ** -0.5),
        "conv_dw": nrm((L, CONV_W, C_CONV), CONV_W ** -0.5),
        "conv_dw_b": nrm((L, C_CONV), 0.02),
        "conv_ln_g": 1.0 + nrm((L, C_CONV), 0.02),
        "conv_ln_b": nrm((L, C_CONV), 0.02),
        "w_conv_out": nrm((L, C_CONV, D_MODEL), C_CONV ** -0.5),
        "b_conv_out": nrm((L, D_MODEL), 0.02),
        "w_out": nrm((L, D_MODEL, D_MODEL), D_MODEL ** -0.5),
        "ln2": 1.0 + nrm((L, D_MODEL), 0.02),
        "w_ff1": nrm((L, D_MODEL, D_FF), D_MODEL ** -0.5),
        "w_ff2": nrm((L, D_FF, D_MODEL), D_FF ** -0.5),
        "ln_ple": 1.0 + nrm((L, D_MODEL), 0.02),
        "w_ple_gate": nrm((L, D_MODEL, D_MODEL), D_MODEL ** -0.5),
        "w_ple": nrm((L, D_PLE, D_MODEL), D_PLE ** -0.5),
    }


def reference(x_prompt, x_sample, cache_k, cache_v, state_conv, p_prompt, p_sample,
              ln1, w_in, b_glu, q_norm, k_norm, sinks, w_o_attn, conv_dw, conv_dw_b,
              conv_ln_g, conv_ln_b, w_conv_out, b_conv_out, w_out, ln2, w_ff1, w_ff2,
              ln_ple, w_ple_gate, w_ple):
    xp, xs = x_prompt, x_sample
    kp_l, vp_l, cp_l, ks_l, vs_l, cs_l = [], [], [], [], [], []
    for i in range(DEPTH):
        lp = dict(ln1=ln1[i], w_in=w_in[i], b_glu=b_glu[i], q_norm=q_norm[i], k_norm=k_norm[i],
                  sinks=sinks[i], w_o_attn=w_o_attn[i], conv_dw=conv_dw[i], conv_dw_b=conv_dw_b[i],
                  conv_ln_g=conv_ln_g[i], conv_ln_b=conv_ln_b[i], w_conv_out=w_conv_out[i],
                  b_conv_out=b_conv_out[i], w_out=w_out[i], ln2=ln2[i], w_ff1=w_ff1[i],
                  w_ff2=w_ff2[i], ln_ple=ln_ple[i], w_ple_gate=w_ple_gate[i], w_ple=w_ple[i])
        xp, kp, vp, cp = prompt_layer(xp, p_prompt[i], lp)
        xs, ks_, vs_, cs_ = sample_layer(xs, p_sample[i], cache_k[i], cache_v[i], state_conv[i], lp)
        kp_l.append(kp); vp_l.append(vp); cp_l.append(cp)
        ks_l.append(ks_); vs_l.append(vs_); cs_l.append(cs_)
    new_k_prompt = jnp.stack(kp_l)
    new_v_prompt = jnp.stack(vp_l)
    new_conv_prompt = jnp.stack(cp_l)
    new_k_sample = jnp.stack(ks_l)
    new_v_sample = jnp.stack(vs_l)
    new_conv_sample = jnp.stack(cs_l)
    return (xp, xs, new_k_prompt, new_v_prompt, new_conv_prompt, new_k_sample, new_v_sample, new_conv_sample)
```

```cpp
#include <hip/hip_runtime.h>
#include <hip/hip_cooperative_groups.h>
#include <cstdio>
#include <cstdint>
namespace cg = cooperative_groups;

#define LAS __attribute__((address_space(3)))
typedef unsigned short bf16_t;
typedef short bf16x8 __attribute__((ext_vector_type(8)));
typedef float f32x4 __attribute__((ext_vector_type(4)));
typedef float f32x2 __attribute__((ext_vector_type(2)));
typedef float f32x16 __attribute__((ext_vector_type(16)));
typedef unsigned u32x4 __attribute__((ext_vector_type(4)));
typedef unsigned u32x2 __attribute__((ext_vector_type(2)));

constexpr int SEQ = 8192, NBATCH = 4, MP = NBATCH * SEQ, NS = 128, MT = MP + NS, DM = 1024, DIN = 5632, DFF = 4096, DPLE = 256;
constexpr float EPS = 1e-6f, LOG2E = 1.4426950408889634f, QSCALE = 0.125f * 1.4426950408889634f, NEGBIG = -1e30f;

typedef __bf16 bf16x2_t __attribute__((ext_vector_type(2)));
__device__ __forceinline__ unsigned cvt_pk_bf16(float lo, float hi) { const f32x2 v = {lo, hi}; return __builtin_bit_cast(unsigned, __builtin_convertvector(v, bf16x2_t)); }
__device__ __forceinline__ float fsigmoid(float x) { return __builtin_amdgcn_rcpf(1.f + __builtin_amdgcn_exp2f(-LOG2E * x)); }
__device__ __forceinline__ float bf_lo(unsigned w) { return __uint_as_float(w << 16); }
__device__ __forceinline__ float bf_hi(unsigned w) { return __uint_as_float(w & 0xffff0000u); }
__device__ __forceinline__ float wave_sum(float v) {
#pragma unroll
    for (int o = 1; o < 64; o <<= 1) v += __shfl_xor(v, o);
    return v;
}
__device__ __forceinline__ float wave_max(float v) {
#pragma unroll
    for (int o = 1; o < 64; o <<= 1) v = fmaxf(v, __shfl_xor(v, o));
    return v;
}
__device__ __forceinline__ f32x2 pk_fma(f32x2 a, f32x2 b, f32x2 c) { f32x2 d; asm("v_pk_fma_f32 %0, %1, %2, %3" : "=v"(d) : "v"(a), "v"(b), "v"(c)); return d; }
template <int CTRL, int RMASK> __device__ __forceinline__ float dpp_f(float v) { return __int_as_float(__builtin_amdgcn_update_dpp(0, __float_as_int(v), CTRL, RMASK, 0xF, false)); }
template <int CTRL> __device__ __forceinline__ float dpp_all(float v) { return __int_as_float(__builtin_amdgcn_mov_dpp(__float_as_int(v), CTRL, 0xF, 0xF, true)); }
__device__ __forceinline__ float wave_sum_l63(float v) {
    v += dpp_all<0xB1>(v); v += dpp_all<0x4E>(v); v += dpp_all<0x141>(v); v += dpp_all<0x140>(v);
    v += dpp_f<0x142, 0xA>(v); v += dpp_f<0x143, 0xC>(v); return v; }
__host__ __device__ __forceinline__ int perm_in(int n) {
    const int pn = n >> 8, j = n & 255, bj = j >> 7, wc = (j >> 5) & 3, w = j & 31;
    if (pn < 5) return (pn < 4 ? 256 * pn : 1024) + 64 * wc + 32 * bj + w;
    if (pn == 5) return 1280 + j;
    if (pn < 14) return 1536 + 1024 * bj + 128 * (pn - 6) + (j & 127);
    return 3584 + 1024 * bj + 128 * (pn - 14) + (j & 127);
}

namespace pg8 {
constexpr int BM = 256, BK = 64, HALF = 128, HTB = HALF * BK * 2, STAGE_BYTES = 8 * HTB, NXCD = 8, WGM = 4;
__host__ __device__ __forceinline__ int lds_byte(int r, int c) { const int st = (r >> 4) * 2 + (c >> 5), rr = r & 15, cc = c & 31, ob = rr * 64 + cc * 2; return st * 1024 + (ob ^ (((ob >> 9) & 1) << 5)); }
__host__ __device__ __forceinline__ void stage_rc(int b, int& R, int& C) { const int st = b / 1024, sb = b % 1024, swz = sb ^ (((sb >> 9) & 1) << 5); R = (st >> 1) * 16 + swz / 64; C = (st & 1) * 32 + (swz % 64) / 2; }
__host__ __device__ __forceinline__ int perm32(int rho) { const int n = rho >> 4, i = rho & 15; return 8 * (i >> 2) + 4 * n + (i & 3); }

struct Unit { int pm, pn; };
struct Gemm { const bf16_t* A; const bf16_t* Bt; int lda, ldb; int M, N, K; };

struct StaticOrder {
    int nM, nN, nwg, G, c;
    __host__ __device__ void init(int M, int N, int G_, int c_) { nM = M / BM; nN = N / BM; nwg = nM * nN; G = G_; c = c_; }
    __host__ __device__ bool next(int i, Unit& u) const {
        const long L = (long)i * G + c; if (L >= nwg) return false;
        int wgid = (int)L; { const int q = nwg / NXCD, r = nwg % NXCD, xcd = wgid % NXCD, off = wgid / NXCD; wgid = (xcd < r ? xcd * (q + 1) : r * (q + 1) + (xcd - r) * q) + off; }
        const int nig = WGM * nN, gid = wgid / nig, fm = gid * WGM, gsz = (nM - fm) < WGM ? (nM - fm) : WGM;
        u.pm = fm + ((wgid % nig) % gsz); u.pn = (wgid % nig) / gsz; return true;
    }
};

template <class Epi, bool DUAL = false>
__device__ __forceinline__ void gemm_phase(LAS unsigned char* lds, const Gemm g, const StaticOrder& S, const Epi& E, const Gemm g1 = Gemm{}) {
    int tid_ = threadIdx.x; asm volatile("" : "+v"(tid_));
    const int tid = tid_, wid = __builtin_amdgcn_readfirstlane(tid >> 6), lane = tid & 63, wr = wid >> 2, wc = wid & 3, fr = lane & 15, fq = lane >> 4;
    unsigned voffA[2], voffB[2];
#pragma unroll
    for (int i = 0; i < 2; ++i) { int R, C; stage_rc(tid * 16 + i * 8192, R, C); const int Rb = (R & ~31) + perm32(R & 31);
        voffA[i] = (unsigned)(R * g.lda + C) * 2u; voffB[i] = (unsigned)(Rb * g.ldb + C) * 2u; }
    const size_t kstep = (size_t)(BK * 2);
    const size_t hsA = (size_t)HALF * g.lda * 2, hsB = (size_t)HALF * g.ldb * 2;
    const size_t tsA = 2 * hsA, tsB = 2 * hsB;
    const unsigned ldsw = (unsigned)wid * 1024u;
    const int aoff = lds_byte(wr * 64 + fr, fq * 8), boff = lds_byte(wc * 32 + fr, fq * 8);
#define PG8_SA(b, h) (((b) * 2 + (h)) * HTB)
#define PG8_SB(b, h) ((4 + (b) * 2 + (h)) * HTB)
#define PG8_STAGE(bufoff, gbase, voff) do { _Pragma("unroll") for (int _i = 0; _i < 2; ++_i) \
        __builtin_amdgcn_global_load_lds((const unsigned*)((const char*)(gbase) + (voff)[_i]), (LAS unsigned*)(lds + (bufoff) + ldsw + _i * 8192), 16, 0, 0); } while (0)
#define PG8_LDA(dst, b, h) do { _Pragma("unroll") for (int m = 0; m < 4; ++m) _Pragma("unroll") for (int k = 0; k < 2; ++k) dst[m][k] = *(const LAS bf16x8*)(lds + PG8_SA(b, h) + aoff + m * 2048 + k * 1024); } while (0)
#define PG8_LDB(dst, b, h) do { _Pragma("unroll") for (int n = 0; n < 2; ++n) _Pragma("unroll") for (int k = 0; k < 2; ++k) dst[n][k] = *(const LAS bf16x8*)(lds + PG8_SB(b, h) + boff + n * 2048 + k * 1024); } while (0)
#define PG8_MMA(ai, bj, At, Bt) do { __builtin_amdgcn_s_setprio(1); _Pragma("unroll") for (int m = 0; m < 4; ++m) _Pragma("unroll") for (int n = 0; n < 2; ++n) _Pragma("unroll") for (int k = 0; k < 2; ++k) \
        acc[ai][bj][m][n] = __builtin_amdgcn_mfma_f32_16x16x32_bf16(Bt[n][k], At[m][k], acc[ai][bj][m][n], 0, 0, 0); __builtin_amdgcn_s_setprio(0); } while (0)
#define PG8_WAIT_V(n) asm volatile("s_waitcnt vmcnt(" #n ")" ::: "memory")
#define PG8_WAIT_L(n) asm volatile("s_waitcnt lgkmcnt(" #n ")" ::: "memory")
#define PG8_BAR __builtin_amdgcn_s_barrier()
#define PG8_SCHED __builtin_amdgcn_sched_barrier(0)
    Unit cur, nxt; int ui = 0;
    if (!S.next(0, cur)) return;
    f32x4 acc[2][2][4][2];
#pragma unroll
    for (int a = 0; a < 2; ++a)
#pragma unroll
        for (int b = 0; b < 2; ++b)
#pragma unroll
            for (int m = 0; m < 4; ++m)
#pragma unroll
                for (int n = 0; n < 2; ++n) acc[a][b][m][n] = (f32x4){0.f, 0.f, 0.f, 0.f};
    bf16x8 At[4][2], B0[2][2], B1[2][2];
    const char* cA = (const char*)g.A + (size_t)cur.pm * tsA; const char* cB = (const char*)g.Bt + (size_t)cur.pn * tsB;
    int nt = g.K / BK;
    PG8_STAGE(PG8_SB(0, 0), cB, voffB); PG8_STAGE(PG8_SB(0, 1), cB + hsB, voffB); PG8_STAGE(PG8_SA(0, 0), cA, voffA); PG8_STAGE(PG8_SA(0, 1), cA + hsA, voffA);
    if (wr == 1) PG8_BAR;
    PG8_WAIT_V(2); PG8_BAR;
    PG8_STAGE(PG8_SB(1, 0), cB + kstep, voffB); PG8_STAGE(PG8_SA(1, 0), cA + kstep, voffA); PG8_STAGE(PG8_SB(1, 1), cB + hsB + kstep, voffB);
    PG8_WAIT_V(6); PG8_BAR;
    for (;;) {
        bool has_next; const char* nA; const char* nB; int nnt = nt;
        if constexpr (DUAL) {
            const int which_n = (ui + 1) & 1;
            has_next = which_n ? true : S.next((ui + 1) >> 1, nxt); if (which_n) nxt = cur;
            const char* gA = (const char*)(which_n ? g1.A : g.A); const char* gB = (const char*)(which_n ? g1.Bt : g.Bt);
            nA = has_next ? gA + (size_t)nxt.pm * tsA : cA; nB = has_next ? gB + (size_t)nxt.pn * tsB : cB; nnt = (which_n ? g1.K : g.K) / BK;
        } else {
            has_next = S.next(ui + 1, nxt);
            nA = has_next ? (const char*)g.A + (size_t)nxt.pm * tsA : cA; nB = has_next ? (const char*)g.Bt + (size_t)nxt.pn * tsB : cB;
        }
        for (int t = 0; t < nt; t += 2) {
            const bool last = (t == nt - 2);
            const char* a1 = cA + (size_t)(t + 1) * kstep;
            const char* a2 = last ? nA : cA + (size_t)(t + 2) * kstep; const char* b2 = last ? nB : cB + (size_t)(t + 2) * kstep;
            const char* a3 = a2 + kstep; const char* b3 = b2 + kstep;
            PG8_LDB(B0, 0, 0); PG8_LDB(B1, 0, 1); PG8_SCHED; PG8_LDA(At, 0, 0); PG8_STAGE(PG8_SA(1, 1), a1 + hsA, voffA);
            PG8_WAIT_V(8); PG8_WAIT_L(0); PG8_BAR; PG8_MMA(0, 0, At, B0); PG8_MMA(0, 1, At, B1); PG8_BAR; PG8_SCHED;
            PG8_LDA(At, 0, 1); PG8_STAGE(PG8_SB(0, 0), b2, voffB); PG8_STAGE(PG8_SB(0, 1), b2 + hsB, voffB); PG8_STAGE(PG8_SA(0, 0), a2, voffA);
            PG8_WAIT_V(8); PG8_WAIT_L(0); PG8_BAR; PG8_MMA(1, 0, At, B0); PG8_MMA(1, 1, At, B1); PG8_BAR; PG8_SCHED;
            PG8_LDB(B0, 1, 0); PG8_LDB(B1, 1, 1); PG8_SCHED; PG8_LDA(At, 1, 0); PG8_STAGE(PG8_SA(0, 1), a2 + hsA, voffA);
            PG8_WAIT_V(8); PG8_WAIT_L(0); PG8_BAR; PG8_MMA(0, 0, At, B0); PG8_MMA(0, 1, At, B1); PG8_BAR; PG8_SCHED;
            PG8_LDA(At, 1, 1); PG8_STAGE(PG8_SB(1, 0), b3, voffB); PG8_STAGE(PG8_SB(1, 1), b3 + hsB, voffB); PG8_STAGE(PG8_SA(1, 0), a3, voffA);
            PG8_WAIT_V(8); PG8_WAIT_L(0); PG8_BAR; PG8_MMA(1, 0, At, B0); PG8_MMA(1, 1, At, B1); PG8_BAR; PG8_SCHED;
            if constexpr (Epi::HOOK_T > 0) { if (t + 2 == Epi::HOOK_T) E.mid(acc, cur, wr, wc, fr, fq); }
        }
        if (wr == 0) PG8_BAR;
        E(acc, cur, wr, wc, fr, fq, DUAL ? (ui & 1) : 0);
        if (!has_next) break;
#pragma unroll
        for (int a = 0; a < 2; ++a)
#pragma unroll
            for (int b = 0; b < 2; ++b)
#pragma unroll
                for (int m = 0; m < 4; ++m)
#pragma unroll
                    for (int n = 0; n < 2; ++n) acc[a][b][m][n] = (f32x4){0.f, 0.f, 0.f, 0.f};
        cur = nxt; cA = nA; cB = nB; nt = nnt; ++ui;
        if (wr == 1) PG8_BAR;
    }
    PG8_WAIT_V(0);
    PG8_BAR;
#undef PG8_SA
#undef PG8_SB
#undef PG8_STAGE
#undef PG8_LDA
#undef PG8_LDB
#undef PG8_MMA
#undef PG8_WAIT_V
#undef PG8_WAIT_L
#undef PG8_BAR
#undef PG8_SCHED
}
}

typedef f32x4 AccT[2][2][4][2];
#define ACC_E(acc, ai, bj, m, e) ((acc)[ai][bj][m][(e) >> 2][(e) & 3])
__device__ __forceinline__ u32x4 pack8(const float* v) { u32x4 w; w.x = cvt_pk_bf16(v[0], v[1]); w.y = cvt_pk_bf16(v[2], v[3]); w.z = cvt_pk_bf16(v[4], v[5]); w.w = cvt_pk_bf16(v[6], v[7]); return w; }

struct EpiIn {
    static constexpr int HOOK_T = 0;
    bf16_t *q, *k, *v, *a; unsigned short* gates;
    const float *qn, *kn, *bglu; const f32x2* rope;
    float *out_nk, *out_nv, *out_nc;
    __device__ __forceinline__ void operator()(const AccT& acc, const pg8::Unit& u, int wr, int wc, int fr, int fq, int which) const {
        asm volatile("" : "+v"(fr), "+v"(fq));
        const int pn = u.pn; const int row0 = u.pm * 256 + wr * 64 + fr;
        const bool lastb = (u.pm & 31) == 31; const int b = u.pm >> 5;
        if (pn < 5) {
            const bool isq = pn < 4; const float* nw = isq ? qn : kn; const float osc = isq ? QSCALE : 1.f;
            float wn[2][8];
#pragma unroll
            for (int bj = 0; bj < 2; ++bj) { const f32x4 w0 = *(const f32x4*)(nw + 32 * bj + 8 * fq), w1 = *(const f32x4*)(nw + 32 * bj + 8 * fq + 4);
                wn[bj][0] = w0[0]; wn[bj][1] = w0[1]; wn[bj][2] = w0[2]; wn[bj][3] = w0[3]; wn[bj][4] = w1[0]; wn[bj][5] = w1[1]; wn[bj][6] = w1[2]; wn[bj][7] = w1[3]; }
            f32x4 cs[2][4]; u32x4 pk1[2], pk2[2];
#pragma unroll
            for (int qt = 0; qt < 4; ++qt) {
                const int ai = qt >> 1, mb = (qt & 1) * 2;
#pragma unroll
                for (int mm = 0; mm < 2; ++mm) { const int pos = (row0 + ai * 128 + (mb + mm) * 16) & (SEQ - 1); const f32x4* rp = (const f32x4*)(rope + (size_t)pos * 32 + 8 * fq);
#pragma unroll
                    for (int e2 = 0; e2 < 4; ++e2) cs[mm][e2] = rp[e2]; }
                asm volatile("" ::: "memory");
                if (qt > 0) { const int pai = (qt - 1) >> 1, pmb = ((qt - 1) & 1) * 2;
#pragma unroll
                    for (int mm = 0; mm < 2; ++mm) { const int row = row0 + pai * 128 + (pmb + mm) * 16;
                        bf16_t* dst = isq ? q + (size_t)row * DM + (4 * pn + wc) * 64 + 8 * fq : k + (size_t)row * 256 + wc * 64 + 8 * fq;
                        *(u32x4*)dst = pk1[mm]; *(u32x4*)(dst + 32) = pk2[mm]; }
                    asm volatile("" ::: "memory");
                }
#pragma unroll
                for (int mm = 0; mm < 2; ++mm) { const int m = mb + mm;
                    const int row = row0 + ai * 128 + m * 16; const int pos = row & (SEQ - 1);
                    float ss = 0.f;
#pragma unroll
                    for (int bj = 0; bj < 2; ++bj)
#pragma unroll
                        for (int e = 0; e < 8; ++e) { const float x = ACC_E(acc, ai, bj, m, e); ss += x * x; }
                    ss += __shfl_xor(ss, 16); ss += __shfl_xor(ss, 32);
                    const float rs = rsqrtf(ss * (1.f / 64.f) + EPS);
                    float o1[8], o2[8];
#pragma unroll
                    for (int e2 = 0; e2 < 4; ++e2) { const f32x4 c4 = cs[mm][e2];
                        { const int e = 2 * e2; const float x1 = ACC_E(acc, ai, 0, m, e) * rs * wn[0][e], x2 = ACC_E(acc, ai, 1, m, e) * rs * wn[1][e];
                          o1[e] = (x1 * c4[0] - x2 * c4[1]) * osc; o2[e] = (x2 * c4[0] + x1 * c4[1]) * osc; }
                        { const int e = 2 * e2 + 1; const float x1 = ACC_E(acc, ai, 0, m, e) * rs * wn[0][e], x2 = ACC_E(acc, ai, 1, m, e) * rs * wn[1][e];
                          o1[e] = (x1 * c4[2] - x2 * c4[3]) * osc; o2[e] = (x2 * c4[2] + x1 * c4[3]) * osc; } }
                    pk1[mm] = pack8(o1); pk2[mm] = pack8(o2);
                    if (!isq && lastb && ai == 1) { float* f = out_nk + ((size_t)(b * 128 + (pos - (SEQ - 128))) * 256) + wc * 64 + 8 * fq;
                        *(f32x4*)f = (f32x4){o1[0], o1[1], o1[2], o1[3]}; *(f32x4*)(f + 4) = (f32x4){o1[4], o1[5], o1[6], o1[7]};
                        *(f32x4*)(f + 32) = (f32x4){o2[0], o2[1], o2[2], o2[3]}; *(f32x4*)(f + 36) = (f32x4){o2[4], o2[5], o2[6], o2[7]}; }
                }
            }
#pragma unroll
            for (int mm = 0; mm < 2; ++mm) { const int row = row0 + 128 + (2 + mm) * 16;
                bf16_t* dst = isq ? q + (size_t)row * DM + (4 * pn + wc) * 64 + 8 * fq : k + (size_t)row * 256 + wc * 64 + 8 * fq;
                *(u32x4*)dst = pk1[mm]; *(u32x4*)(dst + 32) = pk2[mm]; }
        } else if (pn == 5) {
#pragma unroll
            for (int ai = 0; ai < 2; ++ai)
#pragma unroll
                for (int m = 0; m < 4; ++m) {
                    const int row = row0 + ai * 128 + m * 16; const int pos = row & (SEQ - 1);
#pragma unroll
                    for (int bj = 0; bj < 2; ++bj) { const int col = 128 * bj + 32 * wc + 8 * fq;
                        float o[8];
#pragma unroll
                        for (int e = 0; e < 8; ++e) o[e] = ACC_E(acc, ai, bj, m, e);
                        *(u32x4*)(v + (size_t)row * 256 + col) = pack8(o);
                        if (lastb && ai == 1) { float* f = out_nv + (size_t)(b * 128 + (pos - (SEQ - 128))) * 256 + col;
                            *(f32x4*)f = acc[ai][bj][m][0]; *(f32x4*)(f + 4) = acc[ai][bj][m][1]; } }
                }
        } else if (pn < 14) {
            const int c0 = 128 * (pn - 6) + 32 * wc + 8 * fq;
            float bv[8], bg[8];
            { const f32x4 a0 = *(const f32x4*)(bglu + c0), a1 = *(const f32x4*)(bglu + c0 + 4), g0 = *(const f32x4*)(bglu + DM + c0), g1 = *(const f32x4*)(bglu + DM + c0 + 4);
#pragma unroll
              for (int e = 0; e < 4; ++e) { bv[e] = a0[e]; bv[e + 4] = a1[e]; bg[e] = g0[e]; bg[e + 4] = g1[e]; } }
#pragma unroll
            for (int ai = 0; ai < 2; ++ai)
#pragma unroll
                for (int m = 0; m < 4; ++m) {
                    const int row = row0 + ai * 128 + m * 16; const int pos = row & (SEQ - 1);
                    float o[8];
#pragma unroll
                    for (int e = 0; e < 8; ++e) o[e] = (ACC_E(acc, ai, 0, m, e) + bv[e]) * fsigmoid(ACC_E(acc, ai, 1, m, e) + bg[e]);
                    *(u32x4*)(a + (size_t)row * DM + c0) = pack8(o);
                    if (lastb && ai == 1 && pos >= SEQ - 30) { float* f = out_nc + (size_t)(b * 30 + (pos - (SEQ - 30))) * DM + c0;
                        *(f32x4*)f = (f32x4){o[0], o[1], o[2], o[3]}; *(f32x4*)(f + 4) = (f32x4){o[4], o[5], o[6], o[7]}; }
                }
        } else {
            const int c0 = 128 * (pn - 14) + 32 * wc + 8 * fq;
#pragma unroll
            for (int ai = 0; ai < 2; ++ai)
#pragma unroll
                for (int m = 0; m < 4; ++m) {
                    const int row = row0 + ai * 128 + m * 16;
                    unsigned g[8];
#pragma unroll
                    for (int e = 0; e < 8; ++e) { const unsigned qa = (unsigned)(fsigmoid(ACC_E(acc, ai, 0, m, e)) * 255.f + 0.5f); unsigned qc = (unsigned)(fsigmoid(ACC_E(acc, ai, 1, m, e)) * 255.f + 0.5f); qc = qc < 1u ? 1u : qc;
                        g[e] = qa | (qc << 8); }
                    u32x4 w; w.x = g[0] | (g[1] << 16); w.y = g[2] | (g[3] << 16); w.z = g[4] | (g[5] << 16); w.w = g[6] | (g[7] << 16);
                    *(u32x4*)(gates + (size_t)row * DM + c0) = w;
                }
        }
    }
};

struct EpiMix {
    static constexpr int HOOK_T = 16;
    const unsigned short* gates; const float* bco; bf16_t* mixed;
    __device__ __forceinline__ void mid(AccT& acc, const pg8::Unit& u, int wr, int wc, int fr, int fq) const {
        asm volatile("" : "+v"(fr), "+v"(fq));
        const int row0 = u.pm * 256 + wr * 64 + fr;
        f32x4 bb[2][2];
#pragma unroll
        for (int bj = 0; bj < 2; ++bj) { const int col = u.pn * 256 + 128 * bj + 32 * wc + 8 * fq; bb[bj][0] = *(const f32x4*)(bco + col); bb[bj][1] = *(const f32x4*)(bco + col + 4); }
#pragma unroll
        for (int ai = 0; ai < 2; ++ai) {
            u32x4 r[4][2];
#pragma unroll
            for (int m = 0; m < 4; ++m)
#pragma unroll
                for (int bj = 0; bj < 2; ++bj) r[m][bj] = *(const u32x4*)(gates + (size_t)(row0 + ai * 128 + m * 16) * DM + u.pn * 256 + 128 * bj + 32 * wc + 8 * fq);
            asm volatile("" ::: "memory");
#pragma unroll
            for (int m = 0; m < 4; ++m)
#pragma unroll
                for (int bj = 0; bj < 2; ++bj) { const u32x4 q = r[m][bj]; const unsigned w[4] = {q.x, q.y, q.z, q.w};
#pragma unroll
                    for (int e2 = 0; e2 < 4; ++e2) {
                        const float a0 = (float)(w[e2] & 0xffu), c0 = (float)((w[e2] >> 8) & 0xffu), a1 = (float)((w[e2] >> 16) & 0xffu), c1 = (float)(w[e2] >> 24);
                        ACC_E(acc, ai, bj, m, 2 * e2) = ACC_E(acc, ai, bj, m, 2 * e2) * (a0 * __builtin_amdgcn_rcpf(c0)) + bb[bj][(2 * e2) >> 2][(2 * e2) & 3];
                        ACC_E(acc, ai, bj, m, 2 * e2 + 1) = ACC_E(acc, ai, bj, m, 2 * e2 + 1) * (a1 * __builtin_amdgcn_rcpf(c1)) + bb[bj][(2 * e2 + 1) >> 2][(2 * e2 + 1) & 3]; } }
            asm volatile("" ::: "memory");
        }
    }
    __device__ __forceinline__ void operator()(const AccT& acc, const pg8::Unit& u, int wr, int wc, int fr, int fq, int which) const {
        asm volatile("" : "+v"(fr), "+v"(fq));
        const int row0 = u.pm * 256 + wr * 64 + fr;
        u32x4 s[4][2], pk[4][2];
#pragma unroll
        for (int ai = 0; ai < 2; ++ai) {
#pragma unroll
            for (int m = 0; m < 4; ++m)
#pragma unroll
                for (int bj = 0; bj < 2; ++bj) s[m][bj] = __builtin_nontemporal_load((const u32x4*)(gates + (size_t)(row0 + ai * 128 + m * 16) * DM + u.pn * 256 + 128 * bj + 32 * wc + 8 * fq));
            asm volatile("" ::: "memory");
            if (ai == 1) {
#pragma unroll
                for (int m = 0; m < 4; ++m)
#pragma unroll
                    for (int bj = 0; bj < 2; ++bj) *(u32x4*)(mixed + (size_t)(row0 + m * 16) * DM + u.pn * 256 + 128 * bj + 32 * wc + 8 * fq) = pk[m][bj];
                asm volatile("" ::: "memory");
            }
#pragma unroll
            for (int m = 0; m < 4; ++m)
#pragma unroll
                for (int bj = 0; bj < 2; ++bj) { const u32x4 q = s[m][bj]; const unsigned w[4] = {q.x, q.y, q.z, q.w}; float o[8];
#pragma unroll
                    for (int e2 = 0; e2 < 4; ++e2) {
                        const float c0 = (float)((w[e2] >> 8) & 0xffu) * (1.f / 255.f), c1 = (float)(w[e2] >> 24) * (1.f / 255.f);
                        o[2 * e2] = ACC_E(acc, ai, bj, m, 2 * e2) * c0; o[2 * e2 + 1] = ACC_E(acc, ai, bj, m, 2 * e2 + 1) * c1; }
                    pk[m][bj] = pack8(o); }
        }
#pragma unroll
        for (int m = 0; m < 4; ++m)
#pragma unroll
            for (int bj = 0; bj < 2; ++bj) *(u32x4*)(mixed + (size_t)(row0 + 128 + m * 16) * DM + u.pn * 256 + 128 * bj + 32 * wc + 8 * fq) = pk[m][bj];
    }
};

template <bool XREC> struct EpiResB {
    static constexpr int HOOK_T = 0;
    bf16_t* hs; float* rss; const float* xinv; const float* ln1;
    __device__ __forceinline__ void operator()(const AccT& acc, const pg8::Unit& u, int wr, int wc, int fr, int fq, int which) const {
        asm volatile("" : "+v"(fr), "+v"(fq));
        const int row0 = u.pm * 256 + wr * 64 + fr;
        u32x4 hv[4][2], pk[4][2]; float rsc[4], sq[4];
#pragma unroll
        for (int ai = 0; ai < 2; ++ai) {
#pragma unroll
            for (int m = 0; m < 4; ++m) { const int row = row0 + ai * 128 + m * 16; rsc[m] = XREC ? xinv[row] : 1.f;
#pragma unroll
                for (int bj = 0; bj < 2; ++bj) hv[m][bj] = *(const u32x4*)(hs + (size_t)row * DM + u.pn * 256 + 128 * bj + 32 * wc + 8 * fq); }
            asm volatile("" ::: "memory");
            if (ai == 1) {
#pragma unroll
                for (int m = 0; m < 4; ++m) { const int row = row0 + m * 16;
#pragma unroll
                    for (int bj = 0; bj < 2; ++bj) *(u32x4*)(hs + (size_t)row * DM + u.pn * 256 + 128 * bj + 32 * wc + 8 * fq) = pk[m][bj];
                    if (fq == 0) atomicAdd(rss + row, sq[m]); }
                asm volatile("" ::: "memory");
            }
#pragma unroll
            for (int m = 0; m < 4; ++m) { float ssq = 0.f;
#pragma unroll
                for (int bj = 0; bj < 2; ++bj) { const u32x4 hb = hv[m][bj];
                    float h[8] = {bf_lo(hb.x), bf_hi(hb.x), bf_lo(hb.y), bf_hi(hb.y), bf_lo(hb.z), bf_hi(hb.z), bf_lo(hb.w), bf_hi(hb.w)};
#pragma unroll
                    for (int e = 0; e < 8; ++e) { const float b = XREC ? h[e] * rsc[m] : h[e]; h[e] = b + ACC_E(acc, ai, bj, m, e); ssq += h[e] * h[e]; }
                    pk[m][bj] = pack8(h); }
                ssq += __shfl_xor(ssq, 16); ssq += __shfl_xor(ssq, 32); sq[m] = ssq; }
        }
#pragma unroll
        for (int m = 0; m < 4; ++m) { const int row = row0 + 128 + m * 16;
#pragma unroll
            for (int bj = 0; bj < 2; ++bj) *(u32x4*)(hs + (size_t)row * DM + u.pn * 256 + 128 * bj + 32 * wc + 8 * fq) = pk[m][bj];
            if (fq == 0) atomicAdd(rss + row, sq[m]); }
    }
};
__device__ __forceinline__ float row_rs1(const float* rss, int row) { return rsqrtf(rss[row] * (1.f / DM) + EPS); }
struct EpiFF1 {
    static constexpr int HOOK_T = 0;
    const float* rss; bf16_t* f;
    __device__ __forceinline__ void operator()(const AccT& acc, const pg8::Unit& u, int wr, int wc, int fr, int fq, int which) const {
        asm volatile("" : "+v"(fr), "+v"(fq));
        const int row0 = u.pm * 256 + wr * 64 + fr;
        float ss[2][4];
#pragma unroll
        for (int ai = 0; ai < 2; ++ai)
#pragma unroll
            for (int m = 0; m < 4; ++m) ss[ai][m] = rss[row0 + ai * 128 + m * 16];
        asm volatile("" ::: "memory");
#pragma unroll
        for (int ai = 0; ai < 2; ++ai)
#pragma unroll
            for (int m = 0; m < 4; ++m) {
                const int row = row0 + ai * 128 + m * 16; const float rs = rsqrtf(ss[ai][m] * (1.f / DM) + EPS);
#pragma unroll
                for (int bj = 0; bj < 2; ++bj) { float o[8];
#pragma unroll
                    for (int e = 0; e < 8; ++e) { const float t = fmaxf(ACC_E(acc, ai, bj, m, e) * rs, 0.f); o[e] = t * t; }
                    __builtin_nontemporal_store(pack8(o), (u32x4*)(f + (size_t)row * DFF + u.pn * 256 + 128 * bj + 32 * wc + 8 * fq)); }
            }
    }
};
struct EpiGate2 {
    static constexpr int HOOK_T = 0;
    const float* rss; const bf16_t* h2; float* y;
    __device__ __forceinline__ void operator()(const AccT& acc, const pg8::Unit& u, int wr, int wc, int fr, int fq, int which) const {
        asm volatile("" : "+v"(fr), "+v"(fq));
        const int row0 = u.pm * 256 + wr * 64 + fr;
        if (which == 0) {
            float ss[2][4];
#pragma unroll
            for (int ai = 0; ai < 2; ++ai)
#pragma unroll
                for (int m = 0; m < 4; ++m) ss[ai][m] = rss[row0 + ai * 128 + m * 16];
            asm volatile("" ::: "memory");
#pragma unroll
            for (int ai = 0; ai < 2; ++ai)
#pragma unroll
                for (int m = 0; m < 4; ++m) {
                    const int row = row0 + ai * 128 + m * 16; const float rs = rsqrtf(ss[ai][m] * (1.f / DM) + EPS);
#pragma unroll
                    for (int bj = 0; bj < 2; ++bj) { const size_t off = (size_t)row * DM + u.pn * 256 + 128 * bj + 32 * wc + 8 * fq; float o[8];
#pragma unroll
                        for (int e = 0; e < 8; ++e) o[e] = fsigmoid(ACC_E(acc, ai, bj, m, e) * rs) * 255.f + 0.5f;
                        u32x2 w; w.x = (unsigned)o[0] | ((unsigned)o[1] << 8) | ((unsigned)o[2] << 16) | ((unsigned)o[3] << 24); w.y = (unsigned)o[4] | ((unsigned)o[5] << 8) | ((unsigned)o[6] << 16) | ((unsigned)o[7] << 24);
                        *(u32x2*)(y + off) = w; }
                }
        } else {
#pragma unroll
            for (int ai = 0; ai < 2; ++ai) {
                u32x4 hb[4][2]; u32x2 gb[4][2];
#pragma unroll
                for (int m = 0; m < 4; ++m)
#pragma unroll
                    for (int bj = 0; bj < 2; ++bj) { const size_t off = (size_t)(row0 + ai * 128 + m * 16) * DM + u.pn * 256 + 128 * bj + 32 * wc + 8 * fq;
                        hb[m][bj] = *(const u32x4*)(h2 + off); gb[m][bj] = *(const u32x2*)(y + off); }
                asm volatile("" ::: "memory");
#pragma unroll
                for (int m = 0; m < 4; ++m)
#pragma unroll
                    for (int bj = 0; bj < 2; ++bj) { const u32x4 hq = hb[m][bj]; const u32x2 gq = gb[m][bj]; const size_t off = (size_t)(row0 + ai * 128 + m * 16) * DM + u.pn * 256 + 128 * bj + 32 * wc + 8 * fq;
                        const float h[8] = {bf_lo(hq.x), bf_hi(hq.x), bf_lo(hq.y), bf_hi(hq.y), bf_lo(hq.z), bf_hi(hq.z), bf_lo(hq.w), bf_hi(hq.w)};
                        const float gt[8] = {(float)(gq.x & 0xffu) * (1.f / 255.f), (float)((gq.x >> 8) & 0xffu) * (1.f / 255.f), (float)((gq.x >> 16) & 0xffu) * (1.f / 255.f), (float)(gq.x >> 24) * (1.f / 255.f),
                                             (float)(gq.y & 0xffu) * (1.f / 255.f), (float)((gq.y >> 8) & 0xffu) * (1.f / 255.f), (float)((gq.y >> 16) & 0xffu) * (1.f / 255.f), (float)(gq.y >> 24) * (1.f / 255.f)};
                        f32x4 o0, o1;
#pragma unroll
                        for (int e = 0; e < 4; ++e) { o0[e] = h[e] + gt[e] * ACC_E(acc, ai, bj, m, e); o1[e] = h[e + 4] + gt[e + 4] * ACC_E(acc, ai, bj, m, e + 4); }
                        *(f32x4*)(y + off) = o0; *(f32x4*)(y + off + 4) = o1; }
                asm volatile("" ::: "memory");
            }
        }
    }
};

struct MiniPart { const bf16_t* A; int lda; const bf16_t* Bt; int ldb; int K; };
__device__ __forceinline__ int crow(int r, int hi) { return (r & 3) + 8 * (r >> 2) + 4 * hi; }
template <int NP, class Epi>
__device__ __forceinline__ void mini_gemm(LAS unsigned char* lds, const MiniPart p0, const MiniPart p1, int N, const Epi& E, int blk, int G, int jlo = 0, int jhi = 1 << 20) {
    int tid_ = threadIdx.x; asm volatile("" : "+v"(tid_));
    const int tid = tid_, wave = __builtin_amdgcn_readfirstlane(tid >> 6), lane = tid & 63, i32 = lane & 31, hi = lane >> 5;
    LAS float* red = (LAS float*)lds;
    const int nitems = 4 * (N >> 5);
    for (int j = jlo, item = blk + jlo * G; j < jhi && item < nitems; ++j, item += G) {
        const int rt = item & 3, ct = item >> 2;
        f32x16 acc[NP];
#pragma unroll
        for (int p = 0; p < NP; ++p) {
            const MiniPart& P = p == 0 ? p0 : p1;
            acc[p] = (f32x16){0.f, 0.f, 0.f, 0.f, 0.f, 0.f, 0.f, 0.f, 0.f, 0.f, 0.f, 0.f, 0.f, 0.f, 0.f, 0.f};
            const int kw = P.K >> 3; const int k0 = wave * kw;
            const bf16_t* ap = P.A + (size_t)(32 * rt + i32) * P.lda + k0 + 8 * hi; const bf16_t* bp = P.Bt + (size_t)(32 * ct + i32) * P.ldb + k0 + 8 * hi;
            if (kw >= 128) {
                for (int kk = 0; kk < kw; kk += 128) {
                    bf16x8 af[8], bfr[8];
#pragma unroll
                    for (int i = 0; i < 8; ++i) { af[i] = *(const bf16x8*)(ap + kk + 16 * i); bfr[i] = *(const bf16x8*)(bp + kk + 16 * i); }
                    asm volatile("" ::: "memory");
#pragma unroll
                    for (int i = 0; i < 8; ++i) acc[p] = __builtin_amdgcn_mfma_f32_32x32x16_bf16(af[i], bfr[i], acc[p], 0, 0, 0);
                }
            } else {
                for (int kk = 0; kk < kw; kk += 32) {
                    const bf16x8 a0 = *(const bf16x8*)(ap + kk), b0 = *(const bf16x8*)(bp + kk), a1 = *(const bf16x8*)(ap + kk + 16), b1 = *(const bf16x8*)(bp + kk + 16);
                    acc[p] = __builtin_amdgcn_mfma_f32_32x32x16_bf16(a0, b0, acc[p], 0, 0, 0); acc[p] = __builtin_amdgcn_mfma_f32_32x32x16_bf16(a1, b1, acc[p], 0, 0, 0);
                }
            }
        }
#pragma unroll
        for (int p = 0; p < NP; ++p)
#pragma unroll
            for (int r = 0; r < 16; ++r) red[((p * 8 + wave) * 32 + crow(r, hi)) * 33 + i32] = acc[p][r];
        __syncthreads();
#pragma unroll
        for (int half = 0; half < 2; ++half) {
            const int i = (tid >> 5) + 16 * half, j = tid & 31; float v[NP];
#pragma unroll
            for (int p = 0; p < NP; ++p) { float s = 0.f;
#pragma unroll
                for (int w = 0; w < 8; ++w) s += red[((p * 8 + w) * 32 + i) * 33 + j];
                v[p] = s; }
            E(32 * rt + i, 32 * ct + j, v);
        }
        __syncthreads();
    }
}
__device__ __forceinline__ float half_sum32(float v) {
#pragma unroll
    for (int o = 1; o < 32; o <<= 1) v += __shfl_xor(v, o);
    return v;
}
__device__ __forceinline__ float row_rs32(const float* rss, int row) { float s = 0.f;
#pragma unroll
    for (int i = 0; i < 8; ++i) { const f32x4 a = *(const f32x4*)(rss + (size_t)row * 32 + 4 * i); s += (a[0] + a[1]) + (a[2] + a[3]); }
    return rsqrtf(s * (1.f / DM) + EPS); }
struct MEpiZ { float* zs; __device__ __forceinline__ void operator()(int row, int col, const float* v) const { zs[(size_t)row * DIN + perm_in(col)] = v[0]; } };
struct MEpiMix { const float* zs; const float* bco; bf16_t* mixed;
    __device__ __forceinline__ void operator()(int row, int col, const float* v) const {
        const float sa = fsigmoid(zs[(size_t)row * DIN + 3584 + col]), sc = fsigmoid(zs[(size_t)row * DIN + 4608 + col]);
        const float r = sa * v[0] + sc * (v[1] + bco[col]);
        mixed[(size_t)row * DM + col] = (bf16_t)(cvt_pk_bf16(r, 0.f) & 0xffffu); } };
struct MEpiRes { const float* base; float* out; bf16_t* ob; float* rss;
    __device__ __forceinline__ void operator()(int row, int col, const float* v) const {
        const float h = base[(size_t)row * DM + col] + v[0]; out[(size_t)row * DM + col] = h; ob[(size_t)row * DM + col] = (bf16_t)(cvt_pk_bf16(h, 0.f) & 0xffffu);
        const float s = half_sum32(h * h); if ((col & 31) == 0) rss[(size_t)row * 32 + (col >> 5)] = s; } };
struct MEpiFF1 { const float* rss; bf16_t* f;
    __device__ __forceinline__ void operator()(int row, int col, const float* v) const {
        const float t = fmaxf(v[0] * row_rs32(rss, row), 0.f); f[(size_t)row * DFF + col] = (bf16_t)(cvt_pk_bf16(t * t, 0.f) & 0xffffu); } };
struct MEpiGate { const float* rss; float* y;
    __device__ __forceinline__ void operator()(int row, int col, const float* v) const {
        const float g = fsigmoid(v[1] * row_rs32(rss, row)); y[(size_t)row * DM + col] += g * v[0]; } };

constexpr size_t MiB = 1u << 20;
constexpr size_t WS_CTL = 0;
constexpr size_t WS_WIN = 2 * MiB, WS_WOC = 14 * MiB, WS_WOUT = 18 * MiB, WS_WFF1 = 20 * MiB, WS_WFF2 = 28 * MiB, WS_WPG = 36 * MiB, WS_WPLE = 118 * MiB;
constexpr size_t WS_ROPE = 39 * MiB, WS_XINV = 41 * MiB + 512 * 1024, WS_RSS1 = 65536, WS_RSS2 = 65536 + 131072;
constexpr size_t WS_ZS = 46 * MiB, WS_AOYC_S = 49 * MiB, WS_MIX_S = WS_AOYC_S + 512 * 1024, WS_HB_S = WS_MIX_S + 256 * 1024, WS_F_S = 50 * MiB, WS_H2B_S = 51 * MiB,
                 WS_PP_S = WS_H2B_S + 256 * 1024, WS_RSS1_S = WS_PP_S + 512 * 1024, WS_RSS2_S = WS_RSS1_S + 16 * 1024;
constexpr size_t WS_U = 52 * MiB;
constexpr size_t WS_PB = 422 * MiB;
constexpr size_t WS_BIG = 134 * MiB;
constexpr size_t WS_Q = WS_BIG, WS_K = WS_BIG + 64 * MiB, WS_V = WS_BIG + 80 * MiB, WS_A = WS_BIG + 96 * MiB, WS_RR = WS_BIG + 160 * MiB, WS_SGC = WS_BIG + 224 * MiB;
constexpr size_t WS_MIXED = WS_Q;
constexpr size_t WS_F = WS_BIG;
constexpr size_t WS_END = 487 * MiB;
static_assert(WS_RSS2_S + 16 * 1024 <= WS_U && WS_U + (size_t)MT * DM * 2 <= WS_WPLE && WS_WPLE + 2 * MiB <= WS_BIG && WS_PB + (size_t)MT * DM * 2 <= WS_END, "ws map");
constexpr size_t OUT_Y = 0, OUT_YS = (size_t)MP * DM, OUT_NK = OUT_YS + (size_t)NS * DM, OUT_NV = OUT_NK + 4 * 128 * 256, OUT_NC = OUT_NV + 4 * 128 * 256,
                 OUT_NKS = OUT_NC + 4 * 30 * DM, OUT_NVS = OUT_NKS + (size_t)NS * 128 * 256, OUT_NCS = OUT_NVS + (size_t)NS * 128 * 256, OUT_END = OUT_NCS + (size_t)NS * 30 * DM;

constexpr int RING_BYTES = 131072, LDS_BYTES = 147456;

struct Args { const float* in[27]; float* out; unsigned char* ws; int ph_lo, ph_hi; };
typedef const __attribute__((address_space(4))) Args* ArgsP;
__device__ __forceinline__ ArgsP kargs() { ArgsP p = (ArgsP)__builtin_amdgcn_kernarg_segment_ptr(); asm volatile("" : "+s"(p)); return p; }
enum { I_XP = 0, I_XS, I_CK, I_CV, I_SC, I_PP, I_PS, I_LN1, I_WIN, I_BGLU, I_QN, I_KN, I_SINKS, I_WOA, I_CDW, I_CDWB, I_CLNG, I_CLNB, I_WCO, I_BCO, I_WOUT, I_LN2, I_WFF1, I_WFF2, I_LNPLE, I_WPG, I_WPLE };

__device__ __forceinline__ unsigned f2bf(float f) { unsigned u = __float_as_uint(f); return (u + 0x7fffu + ((u >> 16) & 1u)) >> 16; }
__device__ __forceinline__ unsigned pk2(float lo, float hi) { return f2bf(lo) | (f2bf(hi) << 16); }
__device__ __forceinline__ void p0_transpose_item(const float* W, int N, int src_col0, int k0, const float* ksc, bf16_t* WT, int ldk, int dst_row0, int dst_k0, LAS float* scr, int lane) {
    float tv[32];
#pragma unroll
    for (int i = 0; i < 32; ++i) { const int kk = 2 * i + (lane >> 5); tv[i] = __builtin_nontemporal_load(&W[(size_t)(k0 + kk) * N + src_col0 + (lane & 31)]); }
    if (ksc) {
#pragma unroll
        for (int i = 0; i < 32; ++i) tv[i] *= ksc[k0 + 2 * i + (lane >> 5)];
    }
#pragma unroll
    for (int i = 0; i < 32; ++i) scr[(2 * i + (lane >> 5)) * 33 + (lane & 31)] = tv[i];
    asm volatile("s_waitcnt lgkmcnt(0)" ::: "memory");
    const int c = lane & 7;
#pragma unroll
    for (int j = 0; j < 4; ++j) { const int n = (lane >> 3) + 8 * j; const LAS float* s = scr + (8 * c) * 33 + n;
        u32x4 o; o.x = pk2(s[0 * 33], s[1 * 33]); o.y = pk2(s[2 * 33], s[3 * 33]); o.z = pk2(s[4 * 33], s[5 * 33]); o.w = pk2(s[6 * 33], s[7 * 33]);
        *(u32x4*)(WT + (size_t)(dst_row0 + n) * ldk + dst_k0 + k0 + 8 * c) = o; }
    asm volatile("s_waitcnt lgkmcnt(0)" ::: "memory");
}

template <int PART> __device__ __forceinline__ void phase0(LAS unsigned char* lds, int blk, int G, int jlo = 0, int jhi = 1 << 20) {
    const ArgsP ap = kargs();
    int tid_ = threadIdx.x; asm volatile("" : "+v"(tid_));
    const int tid = tid_, wave = __builtin_amdgcn_readfirstlane(tid >> 6), lane = tid & 63;
    unsigned char* ws = ap->ws;
    LAS float* scr = (LAS float*)(lds + wave * 16384);
    const int gw = blk * 8 + wave, NGW = G * 8;
    bf16_t* Win_t = (bf16_t*)(ws + WS_WIN); bf16_t* Woc_t = (bf16_t*)(ws + WS_WOC); bf16_t* Wout_t = (bf16_t*)(ws + WS_WOUT); bf16_t* Wff1_t = (bf16_t*)(ws + WS_WFF1);
    bf16_t* Wff2_t = (bf16_t*)(ws + WS_WFF2); bf16_t* Wpg_t = (bf16_t*)(ws + WS_WPG); bf16_t* Wple_t = (bf16_t*)(ws + WS_WPLE);
    constexpr int NITEMS = 2816 + 512 * 3 + 2048 * 2 + 512 + 128;
    constexpr int IT_LO = PART == 0 ? 0 : 2816, IT_HI = PART == 0 ? 2816 : PART == 1 ? NITEMS : 0;
    for (int it0 = IT_LO + gw; it0 < IT_HI; it0 += NGW) {
        int it = it0;
        if (it < 2816) { const int kb = it / 176, nb = it % 176; p0_transpose_item(ap->in[I_WIN], DIN, perm_in(32 * nb), 64 * kb, ap->in[I_LN1], Win_t, DM, 32 * nb, 0, scr, lane); continue; } it -= 2816;
        if (it < 512) { const int kb = it >> 5, nb = it & 31; p0_transpose_item(ap->in[I_WOA], DM, 32 * nb, 64 * kb, nullptr, Woc_t, 2048, 32 * nb, 0, scr, lane); continue; } it -= 512;
        if (it < 512) { const int kb = it >> 5, nb = it & 31; p0_transpose_item(ap->in[I_WCO], DM, 32 * nb, 64 * kb, nullptr, Woc_t, 2048, 32 * nb, 1024, scr, lane); continue; } it -= 512;
        if (it < 512) { const int kb = it >> 5, nb = it & 31; p0_transpose_item(ap->in[I_WOUT], DM, 32 * nb, 64 * kb, nullptr, Wout_t, DM, 32 * nb, 0, scr, lane); continue; } it -= 512;
        if (it < 2048) { const int kb = it >> 7, nb = it & 127; p0_transpose_item(ap->in[I_WFF1], DFF, 32 * nb, 64 * kb, ap->in[I_LN2], Wff1_t, DM, 32 * nb, 0, scr, lane); continue; } it -= 2048;
        if (it < 2048) { const int kb = it >> 5, nb = it & 31; p0_transpose_item(ap->in[I_WFF2], DM, 32 * nb, 64 * kb, nullptr, Wff2_t, DFF, 32 * nb, 0, scr, lane); continue; } it -= 2048;
        if (it < 512) { const int kb = it >> 5, nb = it & 31; p0_transpose_item(ap->in[I_WPG], DM, 32 * nb, 64 * kb, ap->in[I_LNPLE], Wpg_t, DM, 32 * nb, 0, scr, lane); continue; } it -= 512;
        { const int kb = it >> 5, nb = it & 31; p0_transpose_item(ap->in[I_WPLE], DM, 32 * nb, 64 * kb, nullptr, Wple_t, DM, 32 * nb, 0, scr, lane); }
    }
    bf16_t* U = (bf16_t*)(ws + WS_U);
    if constexpr (PART == 0)
    for (int m0 = gw * 4; m0 < MT; m0 += NGW * 4) {
        f32x4 v[4][4];
#pragma unroll
        for (int r = 0; r < 4; ++r) { const int m = m0 + r; const f32x4* xr = (const f32x4*)(m < MP ? ap->in[I_XP] + (size_t)m * DM : ap->in[I_XS] + (size_t)(m - MP) * DM);
#pragma unroll
            for (int j = 0; j < 4; ++j) v[r][j] = __builtin_nontemporal_load(&xr[lane + 64 * j]); }
#pragma unroll
        for (int r = 0; r < 4; ++r) { const int m = m0 + r; float ss = 0.f;
#pragma unroll
            for (int j = 0; j < 4; ++j) ss += (v[r][j][0] * v[r][j][0] + v[r][j][1] * v[r][j][1]) + (v[r][j][2] * v[r][j][2] + v[r][j][3] * v[r][j][3]);
            const float ms = wave_sum(ss) * (1.f / DM) + EPS; const float rs = rsqrtf(ms);
            if (lane == 0) ((float*)(ws + WS_XINV))[m] = sqrtf(ms);
            u32x2* o = (u32x2*)(U + (size_t)m * DM);
#pragma unroll
            for (int j = 0; j < 4; ++j) { u32x2 w; w.x = pk2(v[r][j][0] * rs, v[r][j][1] * rs); w.y = pk2(v[r][j][2] * rs, v[r][j][3] * rs); o[lane + 64 * j] = w; } }
    }
    bf16_t* PB = (bf16_t*)(ws + WS_PB);
    if constexpr (PART == 2)
    for (int j = jlo, m0 = (gw + jlo * NGW) * 8; j < jhi && m0 < MT; ++j, m0 += NGW * 8) {
        f32x4 v[8];
#pragma unroll
        for (int r = 0; r < 8; ++r) { const int m = m0 + r; const f32x4* pr = (const f32x4*)(m < MP ? ap->in[I_PP] + (size_t)m * DPLE : ap->in[I_PS] + (size_t)(m - MP) * DPLE); v[r] = __builtin_nontemporal_load(&pr[lane]); }
#pragma unroll
        for (int r = 0; r < 8; ++r) { u32x2 w; w.x = pk2(v[r][0], v[r][1]); w.y = pk2(v[r][2], v[r][3]); ((u32x2*)(PB + (size_t)(m0 + r) * DM))[lane] = w; }
    }
    f32x2* rope = (f32x2*)(ws + WS_ROPE);
    if constexpr (PART == 0)
    for (int idx = blk * 512 + tid; idx < 8193 * 32; idx += G * 512) {
        const int pr = idx >> 5, f = idx & 31; const int pos = pr < SEQ ? pr : 16384;
        double invd = 1.0; for (int i = 0; i < f; ++i) invd *= 0.74989420933245582730;
        const float invf = (float)invd; const float ang = (float)pos * invf;
        const double x = (double)ang; const double n = rint(x * 0.63661977236758134308);
        double r = fma(-n, 1.57079632679489655800, x); r = fma(-n, 6.12323399573676603587e-17, r);
        const double r2 = r * r;
        const double sp = r * (1.0 + r2 * (-1.0 / 6 + r2 * (1.0 / 120 + r2 * (-1.0 / 5040 + r2 * (1.0 / 362880 + r2 * (-1.0 / 39916800 + r2 * (1.0 / 6227020800.0)))))));
        const double cp = 1.0 + r2 * (-0.5 + r2 * (1.0 / 24 + r2 * (-1.0 / 720 + r2 * (1.0 / 40320 + r2 * (-1.0 / 3628800 + r2 * (1.0 / 479001600 + r2 * (-1.0 / 87178291200.0)))))));
        const int q = ((int)n) & 3;
        const double c = (q == 0) ? cp : (q == 1) ? -sp : (q == 2) ? -cp : sp;
        const double s = (q == 0) ? sp : (q == 1) ? cp : (q == 2) ? -sp : -cp;
        rope[idx] = (f32x2){(float)c, (float)s};
    }
}

struct P2Ctx { const bf16_t *q, *k, *v, *a; bf16_t* aoyc; const float* sinks; };

typedef short v4i16_t __attribute__((ext_vector_type(4)));
struct AttnPre { u32x4 k[3], v[3]; bf16x8 q[4]; };
__device__ __forceinline__ void attn_load(const P2Ctx& c, int unit, AttnPre& P, int tid, int wave, int lane) {
    const int kvh = unit & 3, qblk = (unit >> 2) & 127, b = unit >> 9; const int t0 = qblk * 64;
#pragma unroll
    for (int it = 0; it < 3; ++it) {
        const int ci = tid + it * 512; const int key = ci >> 3, ch = ci & 7; const int t = t0 - 128 + key;
        P.k[it] = (u32x4){0u, 0u, 0u, 0u}; P.v[it] = (u32x4){0u, 0u, 0u, 0u};
        if (t >= 0) { const size_t ro = (size_t)(b * SEQ + t) * 256 + kvh * 64 + ch * 8; P.k[it] = __builtin_nontemporal_load((const u32x4*)(c.k + ro)); P.v[it] = __builtin_nontemporal_load((const u32x4*)(c.v + ro)); }
    }
    const int g = wave & 3, s = wave >> 2, head = kvh * 4 + g, q = lane & 31, hi = lane >> 5;
    const size_t qrow = (size_t)b * SEQ + t0 + 32 * s + q;
#pragma unroll
    for (int ks = 0; ks < 4; ++ks) P.q[ks] = __builtin_nontemporal_load((const bf16x8*)(c.q + qrow * DM + head * 64 + ks * 16 + hi * 8));
}
__device__ __forceinline__ void attn_stage(const AttnPre& P, LAS unsigned char* buf, int tid) {
    LAS unsigned char* Ks = buf; LAS unsigned char* Vt = buf + 27648;
#pragma unroll
    for (int it = 0; it < 3; ++it) {
        const int ci = tid + it * 512; const int key = ci >> 3, ch = ci & 7;
        *(LAS u32x4*)(Ks + key * 144 + ch * 16) = P.k[it];
        *(LAS u32x4*)(Vt + key * 144 + ch * 16) = P.v[it];
    }
}
__device__ __forceinline__ void attn_compute(const P2Ctx& c, int unit, const bf16x8 (&qf)[4], const LAS unsigned char* buf, int wave, int lane) {
    const int kvh = unit & 3, qblk = (unit >> 2) & 127, b = unit >> 9; const int t0 = qblk * 64;
    const LAS unsigned char* Ks = buf; const LAS unsigned char* Vt = buf + 27648;
    const int g = wave & 3, s = wave >> 2, head = kvh * 4 + g, q = lane & 31, hi = lane >> 5;
    const size_t qrow = (size_t)b * SEQ + t0 + 32 * s + q;
    f32x16 sc[5];
#pragma unroll
    for (int kt = 0; kt < 5; ++kt) {
        sc[kt] = (f32x16){0.f, 0.f, 0.f, 0.f, 0.f, 0.f, 0.f, 0.f, 0.f, 0.f, 0.f, 0.f, 0.f, 0.f, 0.f, 0.f};
#pragma unroll
        for (int ks = 0; ks < 4; ++ks) { const bf16x8 kf = *(const LAS bf16x8*)(Ks + (32 * s + 32 * kt + q) * 144 + ks * 32 + hi * 16); sc[kt] = __builtin_amdgcn_mfma_f32_32x32x16_bf16(kf, qf[ks], sc[kt], 0, 0, 0); }
    }
#pragma unroll
    for (int r = 0; r < 16; ++r) { const int i = crow(r, hi); if (i <= q) sc[0][r] = NEGBIG; if (i > q) sc[4][r] = NEGBIG; }
    if (t0 < 128) {
#pragma unroll
        for (int kt = 0; kt < 5; ++kt)
#pragma unroll
            for (int r = 0; r < 16; ++r) { const int tk = t0 - 128 + 32 * s + 32 * kt + crow(r, hi); if (tk < 0) sc[kt][r] = NEGBIG; }
    }
    const float sink2 = c.sinks[head] * LOG2E;
    float mx = sink2;
#pragma unroll
    for (int kt = 0; kt < 5; ++kt)
#pragma unroll
        for (int r = 0; r < 16; ++r) mx = fmaxf(mx, sc[kt][r]);
    mx = fmaxf(mx, __shfl_xor(mx, 32));
    float l = 0.f;
#pragma unroll
    for (int kt = 0; kt < 5; ++kt)
#pragma unroll
        for (int r = 0; r < 16; ++r) { const float p = __builtin_amdgcn_exp2f(sc[kt][r] - mx); sc[kt][r] = p; l += p; }
    l += __shfl_xor(l, 32); l += __builtin_amdgcn_exp2f(sink2 - mx);
    f32x16 o[2];
    o[0] = (f32x16){0.f, 0.f, 0.f, 0.f, 0.f, 0.f, 0.f, 0.f, 0.f, 0.f, 0.f, 0.f, 0.f, 0.f, 0.f, 0.f}; o[1] = o[0];
#pragma unroll
    for (int kt = 0; kt < 5; ++kt)
#pragma unroll
        for (int ks2 = 0; ks2 < 2; ++ks2) {
            u32x4 pw; pw.x = cvt_pk_bf16(sc[kt][8 * ks2 + 0], sc[kt][8 * ks2 + 1]); pw.y = cvt_pk_bf16(sc[kt][8 * ks2 + 2], sc[kt][8 * ks2 + 3]);
            pw.z = cvt_pk_bf16(sc[kt][8 * ks2 + 4], sc[kt][8 * ks2 + 5]); pw.w = cvt_pk_bf16(sc[kt][8 * ks2 + 6], sc[kt][8 * ks2 + 7]);
            const bf16x8 pb = __builtin_bit_cast(bf16x8, pw);
            const int kk0 = 32 * s + 32 * kt + 16 * ks2 + 4 * hi;
#pragma unroll
            for (int dt = 0; dt < 2; ++dt) {
                const LAS unsigned char* vp = Vt + (kk0 + ((lane & 15) >> 2)) * 144 + (32 * dt + 16 * ((lane >> 4) & 1) + 4 * (lane & 3)) * 2;
                const v4i16_t lo = __builtin_amdgcn_ds_read_tr16_b64_v4i16((LAS v4i16_t*)vp), h2 = __builtin_amdgcn_ds_read_tr16_b64_v4i16((LAS v4i16_t*)(vp + 8 * 144));
                const bf16x8 vw = {lo[0], lo[1], lo[2], lo[3], h2[0], h2[1], h2[2], h2[3]};
                o[dt] = __builtin_amdgcn_mfma_f32_32x32x16_bf16(vw, pb, o[dt], 0, 0, 0);
            }
        }
    const float inv = 1.f / l;
    bf16_t* op = c.aoyc + qrow * 2048 + head * 64;
#pragma unroll
    for (int dt = 0; dt < 2; ++dt)
#pragma unroll
        for (int j = 0; j < 4; ++j) { u32x2 w; w.x = cvt_pk_bf16(o[dt][4 * j] * inv, o[dt][4 * j + 1] * inv); w.y = cvt_pk_bf16(o[dt][4 * j + 2] * inv, o[dt][4 * j + 3] * inv);
            *(u32x2*)(op + 32 * dt + 8 * j + 4 * hi) = w; }
}

__device__ __forceinline__ void p2_conv(LAS unsigned char* lds, int blk, int G) {
    const ArgsP ap = kargs();
    int tid_ = threadIdx.x; asm volatile("" : "+v"(tid_));
    const int tid = tid_, wave = __builtin_amdgcn_readfirstlane(tid >> 6), lane = tid & 63;
    unsigned char* ws = ap->ws;
    P2Ctx c; c.q = (const bf16_t*)(ws + WS_Q); c.k = (const bf16_t*)(ws + WS_K); c.v = (const bf16_t*)(ws + WS_V); c.a = (const bf16_t*)(ws + WS_A);
    c.aoyc = (bf16_t*)(ap->out + OUT_Y); c.sinks = ap->in[I_SINKS];
    const float* zs = (const float*)(ws + WS_ZS); bf16_t* aoyc_s = (bf16_t*)(ws + WS_AOYC_S);
    const f32x2* rope = (const f32x2*)(ws + WS_ROPE);
    {
        const int c0 = 2 * tid;
        f32x2 w[31];
#pragma unroll
        for (int j = 0; j < 31; ++j) w[j] = *(const f32x2*)(ap->in[I_CDW] + (size_t)j * DM + c0);
        const f32x2 dwb = *(const f32x2*)(ap->in[I_CDWB] + c0), lg = *(const f32x2*)(ap->in[I_CLNG] + c0), lb = *(const f32x2*)(ap->in[I_CLNB] + c0);
        LAS float* red = (LAS float*)lds;
        LAS float* stat = (LAS float*)(lds + 2048);
        {
            constexpr int NCU = NBATCH * (SEQ / 16);
            unsigned av[46]; int par = 0;
            if (blk < NCU) { const int b = blk >> 9, t0 = (blk & 511) * 16;
#pragma unroll
                for (int r = 0; r < 46; ++r) { const int t = t0 - 30 + r; av[r] = (t >= 0) ? __builtin_nontemporal_load((const unsigned*)(c.a + (size_t)(b * SEQ + t) * DM + c0)) : 0u; } }
            for (int unit = blk; unit < NCU; unit += G) {
                const int b = unit >> 9, t0 = (unit & 511) * 16;
                LAS float* redp = red + par * 256; LAS float* statp = stat + par * 32;
                const int cid = unit * 512 + tid;
                f32x4 cc4 = {0.f, 0.f, 0.f, 0.f}; size_t cdst = 0; bool cok = false;
                if (cid < NS * 29 * 256) { const int sb = cid / (29 * 256), rem = cid - sb * (29 * 256); const int row = rem >> 8, ch = rem & 255; cok = true;
                    cdst = ((size_t)(sb * 30 + row) * 256 + ch) * 4; cc4 = __builtin_nontemporal_load((const f32x4*)(ap->in[I_SC] + ((size_t)(sb * 30 + row + 1) * 256 + ch) * 4)); }
                f32x2 y[16];
                {
                    f32x2 au[46];
#pragma unroll
                    for (int r = 0; r < 46; ++r) au[r] = (f32x2){bf_lo(av[r]), bf_hi(av[r])};
#pragma unroll
                    for (int i = 0; i < 16; ++i) y[i] = dwb;
#pragma unroll
                    for (int ig = 0; ig < 4; ++ig)
#pragma unroll
                        for (int j = 0; j < 31; ++j)
#pragma unroll
                            for (int i = 4 * ig; i < 4 * ig + 4; ++i) y[i] = pk_fma(au[i + j], w[j], y[i]);
                }
                if (unit + G < NCU) { const int nu = unit + G; const int nb = nu >> 9, nt0 = (nu & 511) * 16;
#pragma unroll
                    for (int r = 0; r < 46; ++r) { const int t = nt0 - 30 + r; av[r] = (t >= 0) ? __builtin_nontemporal_load((const unsigned*)(c.a + (size_t)(nb * SEQ + t) * DM + c0)) : 0u; } }
                {
                    float rv[32];
#pragma unroll
                    for (int i = 0; i < 16; ++i) { rv[i] = y[i][0] + y[i][1]; rv[16 + i] = y[i][0] * y[i][0] + y[i][1] * y[i][1]; }
#pragma unroll
                    for (int k = 0; k < 16; ++k) { const auto r = __builtin_amdgcn_permlane32_swap(__float_as_uint(rv[k]), __float_as_uint(rv[k + 16]), false, false); rv[k] = __uint_as_float(r[0]) + __uint_as_float(r[1]); }
#pragma unroll
                    for (int k = 0; k < 8; ++k) { const auto r = __builtin_amdgcn_permlane16_swap(__float_as_uint(rv[k]), __float_as_uint(rv[k + 8]), false, false); rv[k] = __uint_as_float(r[0]) + __uint_as_float(r[1]); }
                    const bool b3 = (lane & 8) != 0, b2 = (lane & 4) != 0, b1 = (lane & 2) != 0;
#pragma unroll
                    for (int k = 0; k < 4; ++k) { const float send = b3 ? rv[k] : rv[k + 4], keep = b3 ? rv[k + 4] : rv[k]; rv[k] = keep + dpp_all<0x140>(send); }
#pragma unroll
                    for (int k = 0; k < 2; ++k) { const float send = b2 ? rv[k] : rv[k + 2], keep = b2 ? rv[k + 2] : rv[k]; rv[k] = keep + dpp_all<0x141>(send); }
                    { const float send = b1 ? rv[0] : rv[1], keep = b1 ? rv[1] : rv[0]; rv[0] = keep + dpp_all<0x4E>(send); }
                    rv[0] += dpp_all<0xB1>(rv[0]);
                    if ((lane & 1) == 0) { const int v = lane >> 1; redp[(wave * 16 + (v & 15)) * 2 + (v >> 4)] = rv[0]; }
                }
                __syncthreads();
                if (tid < 16) { float s = 0.f, qq = 0.f;
#pragma unroll
                    for (int w8 = 0; w8 < 8; ++w8) { s += redp[(w8 * 16 + tid) * 2]; qq += redp[(w8 * 16 + tid) * 2 + 1]; }
                    const float mu = s * (1.f / DM); const float var = fmaxf(qq * (1.f / DM) - mu * mu, 0.f);
                    statp[tid * 2] = mu; statp[tid * 2 + 1] = rsqrtf(var + EPS); }
                __syncthreads();
#pragma unroll
                for (int i = 0; i < 16; ++i) { const float mu = statp[i * 2], rstd = statp[i * 2 + 1];
                    const float y0 = (y[i][0] - mu) * rstd * lg[0] + lb[0], y1 = (y[i][1] - mu) * rstd * lg[1] + lb[1];
                    *(unsigned*)(c.aoyc + (size_t)(b * SEQ + t0 + i) * 2048 + DM + c0) = cvt_pk_bf16(y0 * fsigmoid(y0), y1 * fsigmoid(y1)); }
                if (cok) *(f32x4*)(ap->out + OUT_NCS + cdst) = cc4;
                par ^= 1;
            }
            __syncthreads();
        }
        for (int b = blk; b < NS; b += G) {
            const float* st = ap->in[I_SC] + (size_t)b * 30 * DM + c0; float* nc = ap->out + OUT_NCS + (size_t)b * 30 * DM + c0;
            f32x2 acc = dwb;
#pragma unroll
            for (int j = 0; j < 30; ++j) { const f32x2 h = *(const f32x2*)(st + (size_t)j * DM); acc[0] += h[0] * w[j][0]; acc[1] += h[1] * w[j][1]; }
            const float* z = zs + (size_t)b * DIN; const float* bg = ap->in[I_BGLU];
            f32x2 an;
            an[0] = (z[1536 + c0] + bg[c0]) * fsigmoid(z[2560 + c0] + bg[DM + c0]); an[1] = (z[1536 + c0 + 1] + bg[c0 + 1]) * fsigmoid(z[2560 + c0 + 1] + bg[DM + c0 + 1]);
            *(f32x2*)(nc + (size_t)29 * DM) = an;
            acc[0] += an[0] * w[30][0]; acc[1] += an[1] * w[30][1];
            const float s = wave_sum(acc[0] + acc[1]), qq = wave_sum(acc[0] * acc[0] + acc[1] * acc[1]);
            if (lane == 0) { red[wave * 2] = s; red[wave * 2 + 1] = qq; }
            __syncthreads();
            float S = 0.f, Q = 0.f;
#pragma unroll
            for (int w8 = 0; w8 < 8; ++w8) { S += red[w8 * 2]; Q += red[w8 * 2 + 1]; }
            const float mu = S * (1.f / DM); const float rstd = rsqrtf(fmaxf(Q * (1.f / DM) - mu * mu, 0.f) + EPS);
            const float y0 = (acc[0] - mu) * rstd * lg[0] + lb[0], y1 = (acc[1] - mu) * rstd * lg[1] + lb[1];
            *(unsigned*)(aoyc_s + (size_t)b * 2048 + DM + c0) = cvt_pk_bf16(y0 * fsigmoid(y0), y1 * fsigmoid(y1));
            __syncthreads();
        }
    }
}

__device__ __forceinline__ void p2_attn(LAS unsigned char* lds, int blk, int G) {
    const ArgsP ap = kargs();
    int tid_ = threadIdx.x; asm volatile("" : "+v"(tid_));
    const int tid = tid_, wave = __builtin_amdgcn_readfirstlane(tid >> 6), lane = tid & 63;
    unsigned char* ws = ap->ws;
    P2Ctx c; c.q = (const bf16_t*)(ws + WS_Q); c.k = (const bf16_t*)(ws + WS_K); c.v = (const bf16_t*)(ws + WS_V); c.a = (const bf16_t*)(ws + WS_A);
    c.aoyc = (bf16_t*)(ap->out + OUT_Y); c.sinks = ap->in[I_SINKS];
    const float* zs = (const float*)(ws + WS_ZS); bf16_t* aoyc_s = (bf16_t*)(ws + WS_AOYC_S);
    const f32x2* rope = (const f32x2*)(ws + WS_ROPE);
    {
        constexpr int NU = NBATCH * (SEQ / 64) * 4; constexpr int ABUF = 55296;
        AttnPre P; int par = 0;
        if (blk < NU) attn_load(c, blk, P, tid, wave, lane);
        for (int unit = blk; unit < NU; unit += G) {
            LAS unsigned char* buf = lds + par * ABUF;
            attn_stage(P, buf, tid);
            bf16x8 qf[4];
#pragma unroll
            for (int ks = 0; ks < 4; ++ks) qf[ks] = P.q[ks];
            __syncthreads();
            if (unit + G < NU) attn_load(c, unit + G, P, tid, wave, lane);
            attn_compute(c, unit, qf, buf, wave, lane);
            par ^= 1;
        }
        __syncthreads();
    }
    {
        LAS float* Kf = (LAS float*)lds;
        LAS float* Vf = (LAS float*)(lds + 33280);
        LAS float* qs = (LAS float*)(lds + 66560);
        LAS float* scs = (LAS float*)(lds + 67584);
        float* nk = ap->out + OUT_NKS; float* nv = ap->out + OUT_NVS;
        for (int item = blk; item < NS * 4; item += G) {
            const int b = item >> 2, kvh = item & 3;
            const float* z = zs + (size_t)b * DIN;
            if (wave < 5) {
                const int d = lane; const bool isq = wave < 4;
                const float val = isq ? z[(kvh * 4 + wave) * 64 + d] : z[1024 + kvh * 64 + d];
                const float rs = rsqrtf(wave_sum(val * val) * (1.f / 64.f) + EPS);
                const float xn = val * rs * (isq ? ap->in[I_QN][d] : ap->in[I_KN][d]);
                const float other = __shfl_xor(xn, 32);
                const f32x2 cs = rope[(size_t)SEQ * 32 + (d & 31)];
                const float o = (d < 32) ? (xn * cs[0] - other * cs[1]) : (xn * cs[0] + other * cs[1]);
                if (isq) qs[wave * 64 + d] = o * QSCALE;
                else { Kf[127 * 65 + d] = o; nk[((size_t)(b * 128 + 127) * 4 + kvh) * 64 + d] = o; }
            } else if (wave == 5) {
                const float val = z[1280 + kvh * 64 + lane]; Vf[127 * 65 + lane] = val; nv[((size_t)(b * 128 + 127) * 4 + kvh) * 64 + lane] = val;
            }
            for (int idx = tid; idx < 127 * 16; idx += 512) {
                const int row = idx >> 4, c4 = idx & 15;
                const f32x4 kv4 = __builtin_nontemporal_load((const f32x4*)(ap->in[I_CK] + ((size_t)(b * 128 + row + 1) * 4 + kvh) * 64 + c4 * 4));
                const f32x4 vv4 = __builtin_nontemporal_load((const f32x4*)(ap->in[I_CV] + ((size_t)(b * 128 + row + 1) * 4 + kvh) * 64 + c4 * 4));
#pragma unroll
                for (int e = 0; e < 4; ++e) { Kf[row * 65 + c4 * 4 + e] = kv4[e]; Vf[row * 65 + c4 * 4 + e] = vv4[e]; }
                *(f32x4*)(nk + ((size_t)(b * 128 + row) * 4 + kvh) * 64 + c4 * 4) = kv4; *(f32x4*)(nv + ((size_t)(b * 128 + row) * 4 + kvh) * 64 + c4 * 4) = vv4;
            }
            __syncthreads();
            { const int j = tid >> 2, h = tid & 3; float s = 0.f;
#pragma unroll 16
              for (int d = 0; d < 64; ++d) s += Kf[j * 65 + d] * qs[h * 64 + d];
              scs[h * 128 + j] = s; }
            __syncthreads();
            if (wave < 4) { const float sink2 = ap->in[I_SINKS][kvh * 4 + wave] * LOG2E;
                const float v0 = scs[wave * 128 + lane], v1 = scs[wave * 128 + 64 + lane];
                const float mx = fmaxf(sink2, wave_max(fmaxf(v0, v1)));
                const float p0 = __builtin_amdgcn_exp2f(v0 - mx), p1 = __builtin_amdgcn_exp2f(v1 - mx);
                const float l = wave_sum(p0 + p1) + __builtin_amdgcn_exp2f(sink2 - mx); const float inv = 1.f / l;
                scs[wave * 128 + lane] = p0 * inv; scs[wave * 128 + 64 + lane] = p1 * inv; }
            __syncthreads();
            if (tid < 256) { const int h = tid >> 6, d = tid & 63; float o = 0.f;
#pragma unroll 16
                for (int j = 0; j < 128; ++j) o += scs[h * 128 + j] * Vf[j * 65 + d];
                aoyc_s[(size_t)b * 2048 + (kvh * 4 + h) * 64 + d] = (bf16_t)f2bf(o); }
            __syncthreads();
        }
    }
}


#define XB_TMO      128
#define XB_XCNT(j)  (256  + 64 * (j))
#define XB_XSUB(j)  (1280 + 64 * (j))
#define XB_XGEN(j)  (2304 + 64 * (j))
#define XB_TOP      3328
#define XB_TOPGEN   3392
#define XCD_BAR_WORDS 3456
#define XB_SPIN_CAP (1u << 18)
__device__ __forceinline__ unsigned xb_ld(unsigned* p)              { return __hip_atomic_load(p, __ATOMIC_RELAXED, __HIP_MEMORY_SCOPE_AGENT); }
__device__ __forceinline__ unsigned xb_add(unsigned* p, unsigned v) { return __hip_atomic_fetch_add(p, v, __ATOMIC_RELAXED, __HIP_MEMORY_SCOPE_AGENT); }
__device__ __forceinline__ unsigned xb_xcc_id() { return (unsigned)__builtin_amdgcn_s_getreg((3 << 11) | 20) & 0xFu; }
#define XB_SPIN(cond, bar) do { unsigned _sp = 0; while (cond) { __builtin_amdgcn_s_sleep(12); \
    if ((++_sp & 255u) == 0u) { if (xb_ld(&(bar)[XB_TMO])) break; if (_sp > XB_SPIN_CAP) { atomicAdd(&(bar)[XB_TMO], 1u); break; } } } } while (0)
struct XcdBarrier { unsigned* bar; unsigned x; volatile LAS unsigned* st; };
__device__ __forceinline__ XcdBarrier xcd_barrier_post(unsigned* bar, volatile LAS unsigned* st) {
    XcdBarrier b; b.bar = bar; b.x = xb_xcc_id(); b.st = st;
    if (threadIdx.x == 0) (void)xb_add(&bar[XB_XCNT(b.x)], 1u);
    return b;
}
__device__ __forceinline__ void xcd_barrier_complete(unsigned* bar, unsigned x, unsigned& nloc, unsigned& nx) {
    const unsigned G = gridDim.x * gridDim.y * gridDim.z;
    unsigned sum, cnt, mine, sp = 0u;
    for (;;) {
        sum = 0u; cnt = 0u; mine = 0u;
#pragma unroll
        for (unsigned j = 0; j < 16; ++j) { const unsigned c = xb_ld(&bar[XB_XCNT(j)]); sum += c; cnt += (c > 0u) ? 1u : 0u; mine = (j == x) ? c : mine; }
        if (sum == G) break;
        __builtin_amdgcn_s_sleep(1);
        if ((++sp & 255u) == 0u) { if (xb_ld(&bar[XB_TMO])) break; if (sp > XB_SPIN_CAP) { atomicAdd(&bar[XB_TMO], 1u); break; } }
    }
    nloc = mine > 0u ? mine : 1u; nx = cnt > 0u ? cnt : 1u;
}
__device__ __forceinline__ void xcd_barrier(const XcdBarrier& b) {
    asm volatile("s_waitcnt vmcnt(0)" ::: "memory");
    __syncthreads();
    if (threadIdx.x == 0) {
        unsigned* bar = b.bar;
        __builtin_amdgcn_s_waitcnt(0);
        unsigned nloc = b.st[0], nx = b.st[1];
        if (nloc == 0u) { xcd_barrier_complete(bar, b.x, nloc, nx); b.st[0] = nloc; b.st[1] = nx; }
        const unsigned old = xb_add(&bar[XB_XSUB(b.x)], 1u);
        const unsigned gen = old / nloc;
        if (old + 1u == (gen + 1u) * nloc) {
            __builtin_amdgcn_fence(__ATOMIC_RELEASE, "agent");
            asm volatile("s_waitcnt vmcnt(0)" ::: "memory");
            const unsigned og = xb_add(&bar[XB_TOP], 1u);
            const unsigned tg = og / nx;
            if (og + 1u == (tg + 1u) * nx) xb_add(&bar[XB_TOPGEN], 1u);
            else XB_SPIN(xb_ld(&bar[XB_TOPGEN]) == tg, bar);
            __builtin_amdgcn_fence(__ATOMIC_ACQUIRE, "agent");
            xb_add(&bar[XB_XGEN(b.x)], 1u);
            asm volatile("s_waitcnt vmcnt(0)" ::: "memory");
        } else {
            XB_SPIN(xb_ld(&bar[XB_XGEN(b.x)]) == gen, bar);
            __builtin_amdgcn_fence(__ATOMIC_ACQUIRE, "agent");
            asm volatile("s_waitcnt vmcnt(0)" ::: "memory");
        }
    }
    __syncthreads();
}
constexpr int CW_BAR = 4096;
constexpr size_t CTL_ZERO_BYTES = 65536 + 2 * 131072;
constexpr int MISC_OFF = RING_BYTES + 320;

__global__ void __launch_bounds__(512, 2) fwd(Args args) {
    extern __shared__ __attribute__((aligned(16))) unsigned char lds_raw[];
    LAS unsigned char* lds = (LAS unsigned char*)lds_raw;
    const int blk = blockIdx.x, G = gridDim.x;
#ifndef REPMASK
#define REPMASK 0
#endif
#define REP(k) for (int rep_ = 0; rep_ < 1 + ((REPMASK >> (k)) & 1); ++rep_)
#define IN(k) true
#define SEAM(k) do { XcdBarrier bar_; bar_.bar = (unsigned*)(kargs()->ws + WS_CTL) + CW_BAR; bar_.x = xb_xcc_id(); bar_.st = (volatile LAS unsigned*)(lds + MISC_OFF) + 8; xcd_barrier(bar_); } while (0)
    volatile LAS unsigned* MISC = (volatile LAS unsigned*)(lds + MISC_OFF);
    if (threadIdx.x < 32) MISC[threadIdx.x] = 0u;
    __syncthreads();
    (void)xcd_barrier_post((unsigned*)(kargs()->ws + WS_CTL) + CW_BAR, MISC + 8);
#define VB_ ((blk & 1) ? (blk >> 1) : ((G + 1) >> 1) + (blk >> 1))
#define mb_pre ((blk & 1) ? VB_ : (1 << 30))
#define mb_post ((blk & 1) ? (1 << 30) : VB_)
    if (IN(0)) REP(0) phase0<0>(lds, blk, G);
    SEAM(0);
    if (IN(1)) REP(1) {
        const ArgsP ap = kargs(); unsigned char* ws = ap->ws; bf16_t* U = (bf16_t*)(ws + WS_U);
        pg8::Gemm g{U, (const bf16_t*)(ws + WS_WIN), DM, DM, MP, DIN, DM}; pg8::StaticOrder S; S.init(MP, DIN, G, blk);
        EpiIn E; E.q = (bf16_t*)(ws + WS_Q); E.k = (bf16_t*)(ws + WS_K); E.v = (bf16_t*)(ws + WS_V); E.a = (bf16_t*)(ws + WS_A); E.gates = (unsigned short*)(ws + WS_RR);
        E.qn = ap->in[I_QN]; E.kn = ap->in[I_KN]; E.bglu = ap->in[I_BGLU]; E.rope = (const f32x2*)(ws + WS_ROPE);
        E.out_nk = ap->out + OUT_NK; E.out_nv = ap->out + OUT_NV; E.out_nc = ap->out + OUT_NC;
        MiniPart p{U + (size_t)MP * DM, DM, (const bf16_t*)(ws + WS_WIN), DM, DM}; MEpiZ ME{(float*)(ws + WS_ZS)};
        const int nj = blk < 4 * (DIN >> 5) ? (4 * (DIN >> 5) - blk + G - 1) / G : 0, npre = (nj * (blk & 3) + 1) / 3;
        mini_gemm<1>(lds, p, p, DIN, ME, blk, G, 0, npre);
        pg8::gemm_phase(lds, g, S, E);
        mini_gemm<1>(lds, p, p, DIN, ME, blk, G, npre, nj);
    }
    SEAM(1);
    if (IN(2)) REP(2) { if (blk & 1) p2_attn(lds, blk, G); p2_conv(lds, blk, G); if (!(blk & 1)) p2_attn(lds, blk, G); phase0<1>(lds, blk, G); __syncthreads(); }
    SEAM(2);
    if (IN(3)) REP(3) {
        const ArgsP ap = kargs(); unsigned char* ws = ap->ws; bf16_t* U = (bf16_t*)(ws + WS_U);
        pg8::Gemm g{(const bf16_t*)(ap->out + OUT_Y), (const bf16_t*)(ws + WS_WOC), 2048, 2048, MP, DM, 2048}; pg8::StaticOrder S; S.init(MP, DM, G, blk);
        EpiMix E{(const unsigned short*)(ws + WS_RR), ap->in[I_BCO], (bf16_t*)(ws + WS_MIXED)};
        MiniPart p0{(const bf16_t*)(ws + WS_AOYC_S), 2048, (const bf16_t*)(ws + WS_WOC), 2048, DM};
        MiniPart p1{(const bf16_t*)(ws + WS_AOYC_S) + DM, 2048, (const bf16_t*)(ws + WS_WOC) + DM, 2048, DM};
        MEpiMix ME{(const float*)(ws + WS_ZS), ap->in[I_BCO], (bf16_t*)(ws + WS_MIX_S)};
        mini_gemm<2>(lds, p0, p1, DM, ME, mb_pre, G);
        pg8::gemm_phase(lds, g, S, E);
        mini_gemm<2>(lds, p0, p1, DM, ME, mb_post, G);
    }
    SEAM(3);
    if (IN(4)) REP(4) {
        const ArgsP ap = kargs(); unsigned char* ws = ap->ws; bf16_t* U = (bf16_t*)(ws + WS_U);
        pg8::Gemm g{(const bf16_t*)(ws + WS_MIXED), (const bf16_t*)(ws + WS_WOUT), DM, DM, MP, DM, DM}; pg8::StaticOrder S; S.init(MP, DM, G, blk);
        EpiResB<true> E{U, (float*)(ws + WS_RSS1), (const float*)(ws + WS_XINV), ap->in[I_LN1]};
        MiniPart p{(const bf16_t*)(ws + WS_MIX_S), DM, (const bf16_t*)(ws + WS_WOUT), DM, DM};
        MEpiRes ME{ap->in[I_XS], ap->out + OUT_YS, (bf16_t*)(ws + WS_HB_S), (float*)(ws + WS_RSS1_S)};
        mini_gemm<1>(lds, p, p, DM, ME, mb_pre, G);
        pg8::gemm_phase(lds, g, S, E);
        mini_gemm<1>(lds, p, p, DM, ME, mb_post, G);
    }
    SEAM(4);
    if (IN(5)) REP(5) {
        const ArgsP ap = kargs(); unsigned char* ws = ap->ws; bf16_t* U = (bf16_t*)(ws + WS_U);
        pg8::Gemm g{U, (const bf16_t*)(ws + WS_WFF1), DM, DM, MP, DFF, DM}; pg8::StaticOrder S; S.init(MP, DFF, G, blk);
        EpiFF1 E{(const float*)(ws + WS_RSS1), (bf16_t*)(ws + WS_F)};
        MiniPart p{(const bf16_t*)(ws + WS_HB_S), DM, (const bf16_t*)(ws + WS_WFF1), DM, DM};
        MEpiFF1 ME{(const float*)(ws + WS_RSS1_S), (bf16_t*)(ws + WS_F_S)};
        const int nj = blk < 4 * (DFF >> 5) ? (4 * (DFF >> 5) - blk + G - 1) / G : 0, npre = (nj * (blk & 3) + 1) / 3;
        const int jpre = (2 * (blk & 3)) / 3;
        mini_gemm<1>(lds, p, p, DFF, ME, blk, G, 0, npre);
        phase0<2>(lds, blk, G, 0, jpre);
        pg8::gemm_phase(lds, g, S, E);
        phase0<2>(lds, blk, G, jpre, 1 << 20);
        mini_gemm<1>(lds, p, p, DFF, ME, blk, G, npre, nj);
    }
    SEAM(5);
    if (IN(6)) {
        const ArgsP ap = kargs(); unsigned char* ws = ap->ws; bf16_t* U = (bf16_t*)(ws + WS_U);
        pg8::Gemm g{(const bf16_t*)(ws + WS_F), (const bf16_t*)(ws + WS_WFF2), DFF, DFF, MP, DM, DFF}; pg8::StaticOrder S; S.init(MP, DM, G, blk);
        EpiResB<false> E{U, (float*)(ws + WS_RSS2), nullptr, nullptr};
        MiniPart p{(const bf16_t*)(ws + WS_F_S), DFF, (const bf16_t*)(ws + WS_WFF2), DFF, DFF};
        MEpiRes ME{ap->out + OUT_YS, ap->out + OUT_YS, (bf16_t*)(ws + WS_H2B_S), (float*)(ws + WS_RSS2_S)};
        mini_gemm<1>(lds, p, p, DM, ME, mb_pre, G);
        pg8::gemm_phase(lds, g, S, E);
        mini_gemm<1>(lds, p, p, DM, ME, mb_post, G);
    }
    SEAM(6);
    if (IN(7)) {
        const ArgsP ap = kargs(); unsigned char* ws = ap->ws; bf16_t* U = (bf16_t*)(ws + WS_U);
        MiniPart p0{(const bf16_t*)(ws + WS_PB) + (size_t)MP * DM, DM, (const bf16_t*)(ws + WS_WPLE), DM, DPLE};
        MiniPart p1{(const bf16_t*)(ws + WS_H2B_S), DM, (const bf16_t*)(ws + WS_WPG), DM, DM};
        MEpiGate ME{(const float*)(ws + WS_RSS2_S), ap->out + OUT_YS};
        mini_gemm<2>(lds, p0, p1, DM, ME, mb_pre, G);
        { pg8::Gemm g{U, (const bf16_t*)(ws + WS_WPG), DM, DM, MP, DM, DM}, g1{(const bf16_t*)(ws + WS_PB), (const bf16_t*)(ws + WS_WPLE), DM, DM, MP, DM, DPLE};
          pg8::StaticOrder S; S.init(MP, DM, G, blk);
          EpiGate2 E{(const float*)(ws + WS_RSS2), U, ap->out + OUT_Y};
          pg8::gemm_phase<EpiGate2, true>(lds, g, S, E, g1); }
        mini_gemm<2>(lds, p0, p1, DM, ME, mb_post, G);
    }
#undef IN
#undef SEAM
#undef mb_pre
#undef mb_post
#undef VB_
}

extern "C" void kernel_launch(void* const* d_in, const int* in_sizes, int n_in, void* d_out, int out_size, void* d_ws, size_t ws_size, hipStream_t stream) {
    static int grid = 0;
    if (grid == 0) {
        if (n_in != 27 || (size_t)out_size != OUT_END || ws_size < WS_END) { fprintf(stderr, "kernel_launch: unexpected shapes: n_in %d out %d ws %zu (need %zu)\n", n_in, out_size, ws_size, (size_t)WS_END); grid = -1; return; }
        int dev = 0, cus = 0;
        if (hipGetDevice(&dev) != hipSuccess || hipDeviceGetAttribute(&cus, hipDeviceAttributeMultiprocessorCount, dev) != hipSuccess) { grid = -1; return; }
        if (hipFuncSetAttribute((const void*)fwd, hipFuncAttributeMaxDynamicSharedMemorySize, LDS_BYTES) != hipSuccess) { fprintf(stderr, "kernel_launch: hipFuncSetAttribute failed\n"); grid = -1; return; }
        int per_cu = 0;
        if (hipOccupancyMaxActiveBlocksPerMultiprocessor(&per_cu, (const void*)fwd, 512, LDS_BYTES) != hipSuccess || per_cu < 1) { fprintf(stderr, "kernel_launch: occupancy query says %d blocks per CU\n", per_cu); grid = -1; return; }
        grid = cus;
    }
    if (grid < 0) return;
    Args a{};
    for (int i = 0; i < 27; ++i) a.in[i] = (const float*)d_in[i];
    a.out = (float*)d_out; a.ws = (unsigned char*)d_ws;
    a.ph_lo = 0; a.ph_hi = 8;
    if (hipMemsetAsync((char*)d_ws + WS_CTL, 0, CTL_ZERO_BYTES, stream) != hipSuccess) { fprintf(stderr, "kernel_launch: memset failed\n"); return; }
    hipLaunchKernelGGL(fwd, dim3(grid), dim3(512), LDS_BYTES, stream, a);
    hipError_t e = hipPeekAtLastError();
    if (e != hipSuccess) fprintf(stderr, "kernel_launch: launch failed: %s (grid %d)\n", hipGetErrorString(e), grid);
}
```

```cpp
#include <hip/hip_runtime.h>
#include <hip/hip_cooperative_groups.h>
#include <cstdio>
#include <cstdint>
namespace cg = cooperative_groups;

#define LAS __attribute__((address_space(3)))
typedef unsigned short bf16_t;
typedef short bf16x8 __attribute__((ext_vector_type(8)));
typedef float f32x4 __attribute__((ext_vector_type(4)));
typedef float f32x2 __attribute__((ext_vector_type(2)));
typedef float f32x16 __attribute__((ext_vector_type(16)));
typedef unsigned u32x4 __attribute__((ext_vector_type(4)));
typedef unsigned u32x2 __attribute__((ext_vector_type(2)));

constexpr int SEQ = 8192, NBATCH = 4, MP = NBATCH * SEQ, NS = 128, MT = MP + NS, DM = 1024, DIN = 5632, DFF = 4096, DPLE = 256;
constexpr float EPS = 1e-6f, LOG2E = 1.4426950408889634f, QSCALE = 0.125f * 1.4426950408889634f, NEGBIG = -1e30f;

typedef __bf16 bf16x2_t __attribute__((ext_vector_type(2)));
__device__ __forceinline__ unsigned cvt_pk_bf16(float lo, float hi) { const f32x2 v = {lo, hi}; return __builtin_bit_cast(unsigned, __builtin_convertvector(v, bf16x2_t)); }
__device__ __forceinline__ float fsigmoid(float x) { return __builtin_amdgcn_rcpf(1.f + __builtin_amdgcn_exp2f(-LOG2E * x)); }
__device__ __forceinline__ float bf_lo(unsigned w) { return __uint_as_float(w << 16); }
__device__ __forceinline__ float bf_hi(unsigned w) { return __uint_as_float(w & 0xffff0000u); }
__device__ __forceinline__ float wave_sum(float v) {
#pragma unroll
    for (int o = 1; o < 64; o <<= 1) v += __shfl_xor(v, o);
    return v;
}
__device__ __forceinline__ float wave_max(float v) {
#pragma unroll
    for (int o = 1; o < 64; o <<= 1) v = fmaxf(v, __shfl_xor(v, o));
    return v;
}
__device__ __forceinline__ f32x2 pk_fma(f32x2 a, f32x2 b, f32x2 c) { f32x2 d; asm("v_pk_fma_f32 %0, %1, %2, %3" : "=v"(d) : "v"(a), "v"(b), "v"(c)); return d; }
template <int CTRL, int RMASK> __device__ __forceinline__ float dpp_f(float v) { return __int_as_float(__builtin_amdgcn_update_dpp(0, __float_as_int(v), CTRL, RMASK, 0xF, false)); }
template <int CTRL> __device__ __forceinline__ float dpp_all(float v) { return __int_as_float(__builtin_amdgcn_mov_dpp(__float_as_int(v), CTRL, 0xF, 0xF, true)); }
__device__ __forceinline__ float wave_sum_l63(float v) {
    v += dpp_all<0xB1>(v); v += dpp_all<0x4E>(v); v += dpp_all<0x141>(v); v += dpp_all<0x140>(v);
    v += dpp_f<0x142, 0xA>(v); v += dpp_f<0x143, 0xC>(v); return v; }
__host__ __device__ __forceinline__ int perm_in(int n) {
    const int pn = n >> 8, j = n & 255, bj = j >> 7, wc = (j >> 5) & 3, w = j & 31;
    if (pn < 5) return (pn < 4 ? 256 * pn : 1024) + 64 * wc + 32 * bj + w;
    if (pn == 5) return 1280 + j;
    if (pn < 14) return 1536 + 1024 * bj + 128 * (pn - 6) + (j & 127);
    return 3584 + 1024 * bj + 128 * (pn - 14) + (j & 127);
}

namespace pg8 {
constexpr int BM = 256, BK = 64, HALF = 128, HTB = HALF * BK * 2, STAGE_BYTES = 8 * HTB, NXCD = 8, WGM = 4;
__host__ __device__ __forceinline__ int lds_byte(int r, int c) { const int st = (r >> 4) * 2 + (c >> 5), rr = r & 15, cc = c & 31, ob = rr * 64 + cc * 2; return st * 1024 + (ob ^ (((ob >> 9) & 1) << 5)); }
__host__ __device__ __forceinline__ void stage_rc(int b, int& R, int& C) { const int st = b / 1024, sb = b % 1024, swz = sb ^ (((sb >> 9) & 1) << 5); R = (st >> 1) * 16 + swz / 64; C = (st & 1) * 32 + (swz % 64) / 2; }
__host__ __device__ __forceinline__ int perm32(int rho) { const int n = rho >> 4, i = rho & 15; return 8 * (i >> 2) + 4 * n + (i & 3); }

struct Unit { int pm, pn; };
struct Gemm { const bf16_t* A; const bf16_t* Bt; int lda, ldb; int M, N, K; };

struct StaticOrder {
    int nM, nN, nwg, G, c;
    __host__ __device__ void init(int M, int N, int G_, int c_) { nM = M / BM; nN = N / BM; nwg = nM * nN; G = G_; c = c_; }
    __host__ __device__ bool next(int i, Unit& u) const {
        const long L = (long)i * G + c; if (L >= nwg) return false;
        int wgid = (int)L; { const int q = nwg / NXCD, r = nwg % NXCD, xcd = wgid % NXCD, off = wgid / NXCD; wgid = (xcd < r ? xcd * (q + 1) : r * (q + 1) + (xcd - r) * q) + off; }
        const int nig = WGM * nN, gid = wgid / nig, fm = gid * WGM, gsz = (nM - fm) < WGM ? (nM - fm) : WGM;
        u.pm = fm + ((wgid % nig) % gsz); u.pn = (wgid % nig) / gsz; return true;
    }
};

template <class Epi, bool DUAL = false>
__device__ __forceinline__ void gemm_phase(LAS unsigned char* lds, const Gemm g, const StaticOrder& S, const Epi& E, const Gemm g1 = Gemm{}) {
    int tid_ = threadIdx.x; asm volatile("" : "+v"(tid_));
    const int tid = tid_, wid = __builtin_amdgcn_readfirstlane(tid >> 6), lane = tid & 63, wr = wid >> 2, wc = wid & 3, fr = lane & 15, fq = lane >> 4;
    unsigned voffA[2], voffB[2];
#pragma unroll
    for (int i = 0; i < 2; ++i) { int R, C; stage_rc(tid * 16 + i * 8192, R, C); const int Rb = (R & ~31) + perm32(R & 31);
        voffA[i] = (unsigned)(R * g.lda + C) * 2u; voffB[i] = (unsigned)(Rb * g.ldb + C) * 2u; }
    const size_t kstep = (size_t)(BK * 2);
    const size_t hsA = (size_t)HALF * g.lda * 2, hsB = (size_t)HALF * g.ldb * 2;
    const size_t tsA = 2 * hsA, tsB = 2 * hsB;
    const unsigned ldsw = (unsigned)wid * 1024u;
    const int aoff = lds_byte(wr * 64 + fr, fq * 8), boff = lds_byte(wc * 32 + fr, fq * 8);
#define PG8_SA(b, h) (((b) * 2 + (h)) * HTB)
#define PG8_SB(b, h) ((4 + (b) * 2 + (h)) * HTB)
#define PG8_STAGE(bufoff, gbase, voff) do { _Pragma("unroll") for (int _i = 0; _i < 2; ++_i) \
        __builtin_amdgcn_global_load_lds((const unsigned*)((const char*)(gbase) + (voff)[_i]), (LAS unsigned*)(lds + (bufoff) + ldsw + _i * 8192), 16, 0, 0); } while (0)
#define PG8_LDA(dst, b, h) do { _Pragma("unroll") for (int m = 0; m < 4; ++m) _Pragma("unroll") for (int k = 0; k < 2; ++k) dst[m][k] = *(const LAS bf16x8*)(lds + PG8_SA(b, h) + aoff + m * 2048 + k * 1024); } while (0)
#define PG8_LDB(dst, b, h) do { _Pragma("unroll") for (int n = 0; n < 2; ++n) _Pragma("unroll") for (int k = 0; k < 2; ++k) dst[n][k] = *(const LAS bf16x8*)(lds + PG8_SB(b, h) + boff + n * 2048 + k * 1024); } while (0)
#define PG8_MMA(ai, bj, At, Bt) do { __builtin_amdgcn_s_setprio(1); _Pragma("unroll") for (int m = 0; m < 4; ++m) _Pragma("unroll") for (int n = 0; n < 2; ++n) _Pragma("unroll") for (int k = 0; k < 2; ++k) \
        acc[ai][bj][m][n] = __builtin_amdgcn_mfma_f32_16x16x32_bf16(Bt[n][k], At[m][k], acc[ai][bj][m][n], 0, 0, 0); __builtin_amdgcn_s_setprio(0); } while (0)
#define PG8_WAIT_V(n) asm volatile("s_waitcnt vmcnt(" #n ")" ::: "memory")
#define PG8_WAIT_L(n) asm volatile("s_waitcnt lgkmcnt(" #n ")" ::: "memory")
#define PG8_BAR __builtin_amdgcn_s_barrier()
#define PG8_SCHED __builtin_amdgcn_sched_barrier(0)
    Unit cur, nxt; int ui = 0;
    if (!S.next(0, cur)) return;
    f32x4 acc[2][2][4][2];
#pragma unroll
    for (int a = 0; a < 2; ++a)
#pragma unroll
        for (int b = 0; b < 2; ++b)
#pragma unroll
            for (int m = 0; m < 4; ++m)
#pragma unroll
                for (int n = 0; n < 2; ++n) acc[a][b][m][n] = (f32x4){0.f, 0.f, 0.f, 0.f};
    bf16x8 At[4][2], B0[2][2], B1[2][2];
    const char* cA = (const char*)g.A + (size_t)cur.pm * tsA; const char* cB = (const char*)g.Bt + (size_t)cur.pn * tsB;
    int nt = g.K / BK;
    PG8_STAGE(PG8_SB(0, 0), cB, voffB); PG8_STAGE(PG8_SB(0, 1), cB + hsB, voffB); PG8_STAGE(PG8_SA(0, 0), cA, voffA); PG8_STAGE(PG8_SA(0, 1), cA + hsA, voffA);
    if (wr == 1) PG8_BAR;
    PG8_WAIT_V(2); PG8_BAR;
    PG8_STAGE(PG8_SB(1, 0), cB + kstep, voffB); PG8_STAGE(PG8_SA(1, 0), cA + kstep, voffA); PG8_STAGE(PG8_SB(1, 1), cB + hsB + kstep, voffB);
    PG8_WAIT_V(6); PG8_BAR;
    for (;;) {
        bool has_next; const char* nA; const char* nB; int nnt = nt;
        if constexpr (DUAL) {
            const int which_n = (ui + 1) & 1;
            has_next = which_n ? true : S.next((ui + 1) >> 1, nxt); if (which_n) nxt = cur;
            const char* gA = (const char*)(which_n ? g1.A : g.A); const char* gB = (const char*)(which_n ? g1.Bt : g.Bt);
            nA = has_next ? gA + (size_t)nxt.pm * tsA : cA; nB = has_next ? gB + (size_t)nxt.pn * tsB : cB; nnt = (which_n ? g1.K : g.K) / BK;
        } else {
            has_next = S.next(ui + 1, nxt);
            nA = has_next ? (const char*)g.A + (size_t)nxt.pm * tsA : cA; nB = has_next ? (const char*)g.Bt + (size_t)nxt.pn * tsB : cB;
        }
        for (int t = 0; t < nt; t += 2) {
            const bool last = (t == nt - 2);
            const char* a1 = cA + (size_t)(t + 1) * kstep;
            const char* a2 = last ? nA : cA + (size_t)(t + 2) * kstep; const char* b2 = last ? nB : cB + (size_t)(t + 2) * kstep;
            const char* a3 = a2 + kstep; const char* b3 = b2 + kstep;
            PG8_LDB(B0, 0, 0); PG8_LDB(B1, 0, 1); PG8_SCHED; PG8_LDA(At, 0, 0); PG8_STAGE(PG8_SA(1, 1), a1 + hsA, voffA);
            PG8_WAIT_V(8); PG8_WAIT_L(0); PG8_BAR; PG8_MMA(0, 0, At, B0); PG8_MMA(0, 1, At, B1); PG8_BAR; PG8_SCHED;
            PG8_LDA(At, 0, 1); PG8_STAGE(PG8_SB(0, 0), b2, voffB); PG8_STAGE(PG8_SB(0, 1), b2 + hsB, voffB); PG8_STAGE(PG8_SA(0, 0), a2, voffA);
            PG8_WAIT_V(8); PG8_WAIT_L(0); PG8_BAR; PG8_MMA(1, 0, At, B0); PG8_MMA(1, 1, At, B1); PG8_BAR; PG8_SCHED;
            PG8_LDB(B0, 1, 0); PG8_LDB(B1, 1, 1); PG8_SCHED; PG8_LDA(At, 1, 0); PG8_STAGE(PG8_SA(0, 1), a2 + hsA, voffA);
            PG8_WAIT_V(8); PG8_WAIT_L(0); PG8_BAR; PG8_MMA(0, 0, At, B0); PG8_MMA(0, 1, At, B1); PG8_BAR; PG8_SCHED;
            PG8_LDA(At, 1, 1); PG8_STAGE(PG8_SB(1, 0), b3, voffB); PG8_STAGE(PG8_SB(1, 1), b3 + hsB, voffB); PG8_STAGE(PG8_SA(1, 0), a3, voffA);
            PG8_WAIT_V(8); PG8_WAIT_L(0); PG8_BAR; PG8_MMA(1, 0, At, B0); PG8_MMA(1, 1, At, B1); PG8_BAR; PG8_SCHED;
            if constexpr (Epi::HOOK_T > 0) { if (t + 2 == Epi::HOOK_T) E.mid(acc, cur, wr, wc, fr, fq); }
        }
        if (wr == 0) PG8_BAR;
        E(acc, cur, wr, wc, fr, fq, DUAL ? (ui & 1) : 0);
        if (!has_next) break;
#pragma unroll
        for (int a = 0; a < 2; ++a)
#pragma unroll
            for (int b = 0; b < 2; ++b)
#pragma unroll
                for (int m = 0; m < 4; ++m)
#pragma unroll
                    for (int n = 0; n < 2; ++n) acc[a][b][m][n] = (f32x4){0.f, 0.f, 0.f, 0.f};
        cur = nxt; cA = nA; cB = nB; nt = nnt; ++ui;
        if (wr == 1) PG8_BAR;
    }
    PG8_WAIT_V(0);
    PG8_BAR;
#undef PG8_SA
#undef PG8_SB
#undef PG8_STAGE
#undef PG8_LDA
#undef PG8_LDB
#undef PG8_MMA
#undef PG8_WAIT_V
#undef PG8_WAIT_L
#undef PG8_BAR
#undef PG8_SCHED
}
}

typedef f32x4 AccT[2][2][4][2];
#define ACC_E(acc, ai, bj, m, e) ((acc)[ai][bj][m][(e) >> 2][(e) & 3])
__device__ __forceinline__ u32x4 pack8(const float* v) { u32x4 w; w.x = cvt_pk_bf16(v[0], v[1]); w.y = cvt_pk_bf16(v[2], v[3]); w.z = cvt_pk_bf16(v[4], v[5]); w.w = cvt_pk_bf16(v[6], v[7]); return w; }

struct EpiIn {
    static constexpr int HOOK_T = 0;
    bf16_t *q, *k, *v, *a; unsigned short* gates;
    const float *qn, *kn, *bglu; const f32x2* rope;
    float *out_nk, *out_nv, *out_nc;
    __device__ __forceinline__ void operator()(const AccT& acc, const pg8::Unit& u, int wr, int wc, int fr, int fq, int which) const {
        asm volatile("" : "+v"(fr), "+v"(fq));
        const int pn = u.pn; const int row0 = u.pm * 256 + wr * 64 + fr;
        const bool lastb = (u.pm & 31) == 31; const int b = u.pm >> 5;
        if (pn < 5) {
            const bool isq = pn < 4; const float* nw = isq ? qn : kn; const float osc = isq ? QSCALE : 1.f;
            float wn[2][8];
#pragma unroll
            for (int bj = 0; bj < 2; ++bj) { const f32x4 w0 = *(const f32x4*)(nw + 32 * bj + 8 * fq), w1 = *(const f32x4*)(nw + 32 * bj + 8 * fq + 4);
                wn[bj][0] = w0[0]; wn[bj][1] = w0[1]; wn[bj][2] = w0[2]; wn[bj][3] = w0[3]; wn[bj][4] = w1[0]; wn[bj][5] = w1[1]; wn[bj][6] = w1[2]; wn[bj][7] = w1[3]; }
            f32x4 cs[2][4]; u32x4 pk1[2], pk2[2];
#pragma unroll
            for (int qt = 0; qt < 4; ++qt) {
                const int ai = qt >> 1, mb = (qt & 1) * 2;
#pragma unroll
                for (int mm = 0; mm < 2; ++mm) { const int pos = (row0 + ai * 128 + (mb + mm) * 16) & (SEQ - 1); const f32x4* rp = (const f32x4*)(rope + (size_t)pos * 32 + 8 * fq);
#pragma unroll
                    for (int e2 = 0; e2 < 4; ++e2) cs[mm][e2] = rp[e2]; }
                asm volatile("" ::: "memory");
                if (qt > 0) { const int pai = (qt - 1) >> 1, pmb = ((qt - 1) & 1) * 2;
#pragma unroll
                    for (int mm = 0; mm < 2; ++mm) { const int row = row0 + pai * 128 + (pmb + mm) * 16;
                        bf16_t* dst = isq ? q + (size_t)row * DM + (4 * pn + wc) * 64 + 8 * fq : k + (size_t)row * 256 + wc * 64 + 8 * fq;
                        *(u32x4*)dst = pk1[mm]; *(u32x4*)(dst + 32) = pk2[mm]; }
                    asm volatile("" ::: "memory");
                }
#pragma unroll
                for (int mm = 0; mm < 2; ++mm) { const int m = mb + mm;
                    const int row = row0 + ai * 128 + m * 16; const int pos = row & (SEQ - 1);
                    float ss = 0.f;
#pragma unroll
                    for (int bj = 0; bj < 2; ++bj)
#pragma unroll
                        for (int e = 0; e < 8; ++e) { const float x = ACC_E(acc, ai, bj, m, e); ss += x * x; }
                    ss += __shfl_xor(ss, 16); ss += __shfl_xor(ss, 32);
                    const float rs = rsqrtf(ss * (1.f / 64.f) + EPS);
                    float o1[8], o2[8];
#pragma unroll
                    for (int e2 = 0; e2 < 4; ++e2) { const f32x4 c4 = cs[mm][e2];
                        { const int e = 2 * e2; const float x1 = ACC_E(acc, ai, 0, m, e) * rs * wn[0][e], x2 = ACC_E(acc, ai, 1, m, e) * rs * wn[1][e];
                          o1[e] = (x1 * c4[0] - x2 * c4[1]) * osc; o2[e] = (x2 * c4[0] + x1 * c4[1]) * osc; }
                        { const int e = 2 * e2 + 1; const float x1 = ACC_E(acc, ai, 0, m, e) * rs * wn[0][e], x2 = ACC_E(acc, ai, 1, m, e) * rs * wn[1][e];
                          o1[e] = (x1 * c4[2] - x2 * c4[3]) * osc; o2[e] = (x2 * c4[2] + x1 * c4[3]) * osc; } }
                    pk1[mm] = pack8(o1); pk2[mm] = pack8(o2);
                    if (!isq && lastb && ai == 1) { float* f = out_nk + ((size_t)(b * 128 + (pos - (SEQ - 128))) * 256) + wc * 64 + 8 * fq;
                        *(f32x4*)f = (f32x4){o1[0], o1[1], o1[2], o1[3]}; *(f32x4*)(f + 4) = (f32x4){o1[4], o1[5], o1[6], o1[7]};
                        *(f32x4*)(f + 32) = (f32x4){o2[0], o2[1], o2[2], o2[3]}; *(f32x4*)(f + 36) = (f32x4){o2[4], o2[5], o2[6], o2[7]}; }
                }
            }
#pragma unroll
            for (int mm = 0; mm < 2; ++mm) { const int row = row0 + 128 + (2 + mm) * 16;
                bf16_t* dst = isq ? q + (size_t)row * DM + (4 * pn + wc) * 64 + 8 * fq : k + (size_t)row * 256 + wc * 64 + 8 * fq;
                *(u32x4*)dst = pk1[mm]; *(u32x4*)(dst + 32) = pk2[mm]; }
        } else if (pn == 5) {
#pragma unroll
            for (int ai = 0; ai < 2; ++ai)
#pragma unroll
                for (int m = 0; m < 4; ++m) {
                    const int row = row0 + ai * 128 + m * 16; const int pos = row & (SEQ - 1);
#pragma unroll
                    for (int bj = 0; bj < 2; ++bj) { const int col = 128 * bj + 32 * wc + 8 * fq;
                        float o[8];
#pragma unroll
                        for (int e = 0; e < 8; ++e) o[e] = ACC_E(acc, ai, bj, m, e);
                        *(u32x4*)(v + (size_t)row * 256 + col) = pack8(o);
                        if (lastb && ai == 1) { float* f = out_nv + (size_t)(b * 128 + (pos - (SEQ - 128))) * 256 + col;
                            *(f32x4*)f = acc[ai][bj][m][0]; *(f32x4*)(f + 4) = acc[ai][bj][m][1]; } }
                }
        } else if (pn < 14) {
            const int c0 = 128 * (pn - 6) + 32 * wc + 8 * fq;
            float bv[8], bg[8];
            { const f32x4 a0 = *(const f32x4*)(bglu + c0), a1 = *(const f32x4*)(bglu + c0 + 4), g0 = *(const f32x4*)(bglu + DM + c0), g1 = *(const f32x4*)(bglu + DM + c0 + 4);
#pragma unroll
              for (int e = 0; e < 4; ++e) { bv[e] = a0[e]; bv[e + 4] = a1[e]; bg[e] = g0[e]; bg[e + 4] = g1[e]; } }
#pragma unroll
            for (int ai = 0; ai < 2; ++ai)
#pragma unroll
                for (int m = 0; m < 4; ++m) {
                    const int row = row0 + ai * 128 + m * 16; const int pos = row & (SEQ - 1);
                    float o[8];
#pragma unroll
                    for (int e = 0; e < 8; ++e) o[e] = (ACC_E(acc, ai, 0, m, e) + bv[e]) * fsigmoid(ACC_E(acc, ai, 1, m, e) + bg[e]);
                    *(u32x4*)(a + (size_t)row * DM + c0) = pack8(o);
                    if (lastb && ai == 1 && pos >= SEQ - 30) { float* f = out_nc + (size_t)(b * 30 + (pos - (SEQ - 30))) * DM + c0;
                        *(f32x4*)f = (f32x4){o[0], o[1], o[2], o[3]}; *(f32x4*)(f + 4) = (f32x4){o[4], o[5], o[6], o[7]}; }
                }
        } else {
            const int c0 = 128 * (pn - 14) + 32 * wc + 8 * fq;
#pragma unroll
            for (int ai = 0; ai < 2; ++ai)
#pragma unroll
                for (int m = 0; m < 4; ++m) {
                    const int row = row0 + ai * 128 + m * 16;
                    unsigned g[8];
#pragma unroll
                    for (int e = 0; e < 8; ++e) { const unsigned qa = (unsigned)(fsigmoid(ACC_E(acc, ai, 0, m, e)) * 255.f + 0.5f); unsigned qc = (unsigned)(fsigmoid(ACC_E(acc, ai, 1, m, e)) * 255.f + 0.5f); qc = qc < 1u ? 1u : qc;
                        g[e] = qa | (qc << 8); }
                    u32x4 w; w.x = g[0] | (g[1] << 16); w.y = g[2] | (g[3] << 16); w.z = g[4] | (g[5] << 16); w.w = g[6] | (g[7] << 16);
                    *(u32x4*)(gates + (size_t)row * DM + c0) = w;
                }
        }
    }
};

struct EpiMix {
    static constexpr int HOOK_T = 16;
    const unsigned short* gates; const float* bco; bf16_t* mixed;
    __device__ __forceinline__ void mid(AccT& acc, const pg8::Unit& u, int wr, int wc, int fr, int fq) const {
        asm volatile("" : "+v"(fr), "+v"(fq));
        const int row0 = u.pm * 256 + wr * 64 + fr;
        f32x4 bb[2][2];
#pragma unroll
        for (int bj = 0; bj < 2; ++bj) { const int col = u.pn * 256 + 128 * bj + 32 * wc + 8 * fq; bb[bj][0] = *(const f32x4*)(bco + col); bb[bj][1] = *(const f32x4*)(bco + col + 4); }
#pragma unroll
        for (int ai = 0; ai < 2; ++ai) {
            u32x4 r[4][2];
#pragma unroll
            for (int m = 0; m < 4; ++m)
#pragma unroll
                for (int bj = 0; bj < 2; ++bj) r[m][bj] = *(const u32x4*)(gates + (size_t)(row0 + ai * 128 + m * 16) * DM + u.pn * 256 + 128 * bj + 32 * wc + 8 * fq);
            asm volatile("" ::: "memory");
#pragma unroll
            for (int m = 0; m < 4; ++m)
#pragma unroll
                for (int bj = 0; bj < 2; ++bj) { const u32x4 q = r[m][bj]; const unsigned w[4] = {q.x, q.y, q.z, q.w};
#pragma unroll
                    for (int e2 = 0; e2 < 4; ++e2) {
                        const float a0 = (float)(w[e2] & 0xffu), c0 = (float)((w[e2] >> 8) & 0xffu), a1 = (float)((w[e2] >> 16) & 0xffu), c1 = (float)(w[e2] >> 24);
                        ACC_E(acc, ai, bj, m, 2 * e2) = ACC_E(acc, ai, bj, m, 2 * e2) * (a0 * __builtin_amdgcn_rcpf(c0)) + bb[bj][(2 * e2) >> 2][(2 * e2) & 3];
                        ACC_E(acc, ai, bj, m, 2 * e2 + 1) = ACC_E(acc, ai, bj, m, 2 * e2 + 1) * (a1 * __builtin_amdgcn_rcpf(c1)) + bb[bj][(2 * e2 + 1) >> 2][(2 * e2 + 1) & 3]; } }
            asm volatile("" ::: "memory");
        }
    }
    __device__ __forceinline__ void operator()(const AccT& acc, const pg8::Unit& u, int wr, int wc, int fr, int fq, int which) const {
        asm volatile("" : "+v"(fr), "+v"(fq));
        const int row0 = u.pm * 256 + wr * 64 + fr;
        u32x4 s[4][2], pk[4][2];
#pragma unroll
        for (int ai = 0; ai < 2; ++ai) {
#pragma unroll
            for (int m = 0; m < 4; ++m)
#pragma unroll
                for (int bj = 0; bj < 2; ++bj) s[m][bj] = __builtin_nontemporal_load((const u32x4*)(gates + (size_t)(row0 + ai * 128 + m * 16) * DM + u.pn * 256 + 128 * bj + 32 * wc + 8 * fq));
            asm volatile("" ::: "memory");
            if (ai == 1) {
#pragma unroll
                for (int m = 0; m < 4; ++m)
#pragma unroll
                    for (int bj = 0; bj < 2; ++bj) *(u32x4*)(mixed + (size_t)(row0 + m * 16) * DM + u.pn * 256 + 128 * bj + 32 * wc + 8 * fq) = pk[m][bj];
                asm volatile("" ::: "memory");
            }
#pragma unroll
            for (int m = 0; m < 4; ++m)
#pragma unroll
                for (int bj = 0; bj < 2; ++bj) { const u32x4 q = s[m][bj]; const unsigned w[4] = {q.x, q.y, q.z, q.w}; float o[8];
#pragma unroll
                    for (int e2 = 0; e2 < 4; ++e2) {
                        const float c0 = (float)((w[e2] >> 8) & 0xffu) * (1.f / 255.f), c1 = (float)(w[e2] >> 24) * (1.f / 255.f);
                        o[2 * e2] = ACC_E(acc, ai, bj, m, 2 * e2) * c0; o[2 * e2 + 1] = ACC_E(acc, ai, bj, m, 2 * e2 + 1) * c1; }
                    pk[m][bj] = pack8(o); }
        }
#pragma unroll
        for (int m = 0; m < 4; ++m)
#pragma unroll
            for (int bj = 0; bj < 2; ++bj) *(u32x4*)(mixed + (size_t)(row0 + 128 + m * 16) * DM + u.pn * 256 + 128 * bj + 32 * wc + 8 * fq) = pk[m][bj];
    }
};

template <bool XREC> struct EpiResB {
    static constexpr int HOOK_T = 0;
    bf16_t* hs; float* rss; const float* xinv; const float* ln1;
    __device__ __forceinline__ void operator()(const AccT& acc, const pg8::Unit& u, int wr, int wc, int fr, int fq, int which) const {
        asm volatile("" : "+v"(fr), "+v"(fq));
        const int row0 = u.pm * 256 + wr * 64 + fr;
        u32x4 hv[4][2], pk[4][2]; float rsc[4], sq[4];
#pragma unroll
        for (int ai = 0; ai < 2; ++ai) {
#pragma unroll
            for (int m = 0; m < 4; ++m) { const int row = row0 + ai * 128 + m * 16; rsc[m] = XREC ? xinv[row] : 1.f;
#pragma unroll
                for (int bj = 0; bj < 2; ++bj) hv[m][bj] = *(const u32x4*)(hs + (size_t)row * DM + u.pn * 256 + 128 * bj + 32 * wc + 8 * fq); }
            asm volatile("" ::: "memory");
            if (ai == 1) {
#pragma unroll
                for (int m = 0; m < 4; ++m) { const int row = row0 + m * 16;
#pragma unroll
                    for (int bj = 0; bj < 2; ++bj) *(u32x4*)(hs + (size_t)row * DM + u.pn * 256 + 128 * bj + 32 * wc + 8 * fq) = pk[m][bj];
                    if (fq == 0) atomicAdd(rss + row, sq[m]); }
                asm volatile("" ::: "memory");
            }
#pragma unroll
            for (int m = 0; m < 4; ++m) { float ssq = 0.f;
#pragma unroll
                for (int bj = 0; bj < 2; ++bj) { const u32x4 hb = hv[m][bj];
                    float h[8] = {bf_lo(hb.x), bf_hi(hb.x), bf_lo(hb.y), bf_hi(hb.y), bf_lo(hb.z), bf_hi(hb.z), bf_lo(hb.w), bf_hi(hb.w)};
#pragma unroll
                    for (int e = 0; e < 8; ++e) { const float b = XREC ? h[e] * rsc[m] : h[e]; h[e] = b + ACC_E(acc, ai, bj, m, e); ssq += h[e] * h[e]; }
                    pk[m][bj] = pack8(h); }
                ssq += __shfl_xor(ssq, 16); ssq += __shfl_xor(ssq, 32); sq[m] = ssq; }
        }
#pragma unroll
        for (int m = 0; m < 4; ++m) { const int row = row0 + 128 + m * 16;
#pragma unroll
            for (int bj = 0; bj < 2; ++bj) *(u32x4*)(hs + (size_t)row * DM + u.pn * 256 + 128 * bj + 32 * wc + 8 * fq) = pk[m][bj];
            if (fq == 0) atomicAdd(rss + row, sq[m]); }
    }
};
__device__ __forceinline__ float row_rs1(const float* rss, int row) { return rsqrtf(rss[row] * (1.f / DM) + EPS); }
struct EpiFF1 {
    static constexpr int HOOK_T = 0;
    const float* rss; bf16_t* f;
    __device__ __forceinline__ void operator()(const AccT& acc, const pg8::Unit& u, int wr, int wc, int fr, int fq, int which) const {
        asm volatile("" : "+v"(fr), "+v"(fq));
        const int row0 = u.pm * 256 + wr * 64 + fr;
        float ss[2][4];
#pragma unroll
        for (int ai = 0; ai < 2; ++ai)
#pragma unroll
            for (int m = 0; m < 4; ++m) ss[ai][m] = rss[row0 + ai * 128 + m * 16];
        asm volatile("" ::: "memory");
#pragma unroll
        for (int ai = 0; ai < 2; ++ai)
#pragma unroll
            for (int m = 0; m < 4; ++m) {
                const int row = row0 + ai * 128 + m * 16; const float rs = rsqrtf(ss[ai][m] * (1.f / DM) + EPS);
#pragma unroll
                for (int bj = 0; bj < 2; ++bj) { float o[8];
#pragma unroll
                    for (int e = 0; e < 8; ++e) { const float t = fmaxf(ACC_E(acc, ai, bj, m, e) * rs, 0.f); o[e] = t * t; }
                    __builtin_nontemporal_store(pack8(o), (u32x4*)(f + (size_t)row * DFF + u.pn * 256 + 128 * bj + 32 * wc + 8 * fq)); }
            }
    }
};
struct EpiGate2 {
    static constexpr int HOOK_T = 0;
    const float* rss; const bf16_t* h2; float* y;
    __device__ __forceinline__ void operator()(const AccT& acc, const pg8::Unit& u, int wr, int wc, int fr, int fq, int which) const {
        asm volatile("" : "+v"(fr), "+v"(fq));
        const int row0 = u.pm * 256 + wr * 64 + fr;
        if (which == 0) {
            float ss[2][4];
#pragma unroll
            for (int ai = 0; ai < 2; ++ai)
#pragma unroll
                for (int m = 0; m < 4; ++m) ss[ai][m] = rss[row0 + ai * 128 + m * 16];
            asm volatile("" ::: "memory");
#pragma unroll
            for (int ai = 0; ai < 2; ++ai)
#pragma unroll
                for (int m = 0; m < 4; ++m) {
                    const int row = row0 + ai * 128 + m * 16; const float rs = rsqrtf(ss[ai][m] * (1.f / DM) + EPS);
#pragma unroll
                    for (int bj = 0; bj < 2; ++bj) { const size_t off = (size_t)row * DM + u.pn * 256 + 128 * bj + 32 * wc + 8 * fq; float o[8];
#pragma unroll
                        for (int e = 0; e < 8; ++e) o[e] = fsigmoid(ACC_E(acc, ai, bj, m, e) * rs) * 255.f + 0.5f;
                        u32x2 w; w.x = (unsigned)o[0] | ((unsigned)o[1] << 8) | ((unsigned)o[2] << 16) | ((unsigned)o[3] << 24); w.y = (unsigned)o[4] | ((unsigned)o[5] << 8) | ((unsigned)o[6] << 16) | ((unsigned)o[7] << 24);
                        *(u32x2*)(y + off) = w; }
                }
        } else {
#pragma unroll
            for (int ai = 0; ai < 2; ++ai) {
                u32x4 hb[4][2]; u32x2 gb[4][2];
#pragma unroll
                for (int m = 0; m < 4; ++m)
#pragma unroll
                    for (int bj = 0; bj < 2; ++bj) { const size_t off = (size_t)(row0 + ai * 128 + m * 16) * DM + u.pn * 256 + 128 * bj + 32 * wc + 8 * fq;
                        hb[m][bj] = *(const u32x4*)(h2 + off); gb[m][bj] = *(const u32x2*)(y + off); }
                asm volatile("" ::: "memory");
#pragma unroll
                for (int m = 0; m < 4; ++m)
#pragma unroll
                    for (int bj = 0; bj < 2; ++bj) { const u32x4 hq = hb[m][bj]; const u32x2 gq = gb[m][bj]; const size_t off = (size_t)(row0 + ai * 128 + m * 16) * DM + u.pn * 256 + 128 * bj + 32 * wc + 8 * fq;
                        const float h[8] = {bf_lo(hq.x), bf_hi(hq.x), bf_lo(hq.y), bf_hi(hq.y), bf_lo(hq.z), bf_hi(hq.z), bf_lo(hq.w), bf_hi(hq.w)};
                        const float gt[8] = {(float)(gq.x & 0xffu) * (1.f / 255.f), (float)((gq.x >> 8) & 0xffu) * (1.f / 255.f), (float)((gq.x >> 16) & 0xffu) * (1.f / 255.f), (float)(gq.x >> 24) * (1.f / 255.f),
                                             (float)(gq.y & 0xffu) * (1.f / 255.f), (float)((gq.y >> 8) & 0xffu) * (1.f / 255.f), (float)((gq.y >> 16) & 0xffu) * (1.f / 255.f), (float)(gq.y >> 24) * (1.f / 255.f)};
                        f32x4 o0, o1;
#pragma unroll
                        for (int e = 0; e < 4; ++e) { o0[e] = h[e] + gt[e] * ACC_E(acc, ai, bj, m, e); o1[e] = h[e + 4] + gt[e + 4] * ACC_E(acc, ai, bj, m, e + 4); }
                        *(f32x4*)(y + off) = o0; *(f32x4*)(y + off + 4) = o1; }
                asm volatile("" ::: "memory");
            }
        }
    }
};

struct MiniPart { const bf16_t* A; int lda; const bf16_t* Bt; int ldb; int K; };
__device__ __forceinline__ int crow(int r, int hi) { return (r & 3) + 8 * (r >> 2) + 4 * hi; }
template <int NP, class Epi>
__device__ __forceinline__ void mini_gemm(LAS unsigned char* lds, const MiniPart p0, const MiniPart p1, int N, const Epi& E, int blk, int G, int jlo = 0, int jhi = 1 << 20) {
    int tid_ = threadIdx.x; asm volatile("" : "+v"(tid_));
    const int tid = tid_, wave = __builtin_amdgcn_readfirstlane(tid >> 6), lane = tid & 63, i32 = lane & 31, hi = lane >> 5;
    LAS float* red = (LAS float*)lds;
    const int nitems = 4 * (N >> 5);
    for (int j = jlo, item = blk + jlo * G; j < jhi && item < nitems; ++j, item += G) {
        const int rt = item & 3, ct = item >> 2;
        f32x16 acc[NP];
#pragma unroll
        for (int p = 0; p < NP; ++p) {
            const MiniPart& P = p == 0 ? p0 : p1;
            acc[p] = (f32x16){0.f, 0.f, 0.f, 0.f, 0.f, 0.f, 0.f, 0.f, 0.f, 0.f, 0.f, 0.f, 0.f, 0.f, 0.f, 0.f};
            const int kw = P.K >> 3; const int k0 = wave * kw;
            const bf16_t* ap = P.A + (size_t)(32 * rt + i32) * P.lda + k0 + 8 * hi; const bf16_t* bp = P.Bt + (size_t)(32 * ct + i32) * P.ldb + k0 + 8 * hi;
            if (kw >= 128) {
                for (int kk = 0; kk < kw; kk += 128) {
                    bf16x8 af[8], bfr[8];
#pragma unroll
                    for (int i = 0; i < 8; ++i) { af[i] = *(const bf16x8*)(ap + kk + 16 * i); bfr[i] = *(const bf16x8*)(bp + kk + 16 * i); }
                    asm volatile("" ::: "memory");
#pragma unroll
                    for (int i = 0; i < 8; ++i) acc[p] = __builtin_amdgcn_mfma_f32_32x32x16_bf16(af[i], bfr[i], acc[p], 0, 0, 0);
                }
            } else {
                for (int kk = 0; kk < kw; kk += 32) {
                    const bf16x8 a0 = *(const bf16x8*)(ap + kk), b0 = *(const bf16x8*)(bp + kk), a1 = *(const bf16x8*)(ap + kk + 16), b1 = *(const bf16x8*)(bp + kk + 16);
                    acc[p] = __builtin_amdgcn_mfma_f32_32x32x16_bf16(a0, b0, acc[p], 0, 0, 0); acc[p] = __builtin_amdgcn_mfma_f32_32x32x16_bf16(a1, b1, acc[p], 0, 0, 0);
                }
            }
        }
#pragma unroll
        for (int p = 0; p < NP; ++p)
#pragma unroll
            for (int r = 0; r < 16; ++r) red[((p * 8 + wave) * 32 + crow(r, hi)) * 33 + i32] = acc[p][r];
        __syncthreads();
#pragma unroll
        for (int half = 0; half < 2; ++half) {
            const int i = (tid >> 5) + 16 * half, j = tid & 31; float v[NP];
#pragma unroll
            for (int p = 0; p < NP; ++p) { float s = 0.f;
#pragma unroll
                for (int w = 0; w < 8; ++w) s += red[((p * 8 + w) * 32 + i) * 33 + j];
                v[p] = s; }
            E(32 * rt + i, 32 * ct + j, v);
        }
        __syncthreads();
    }
}
__device__ __forceinline__ float half_sum32(float v) {
#pragma unroll
    for (int o = 1; o < 32; o <<= 1) v += __shfl_xor(v, o);
    return v;
}
__device__ __forceinline__ float row_rs32(const float* rss, int row) { float s = 0.f;
#pragma unroll
    for (int i = 0; i < 8; ++i) { const f32x4 a = *(const f32x4*)(rss + (size_t)row * 32 + 4 * i); s += (a[0] + a[1]) + (a[2] + a[3]); }
    return rsqrtf(s * (1.f / DM) + EPS); }
struct MEpiZ { float* zs; __device__ __forceinline__ void operator()(int row, int col, const float* v) const { zs[(size_t)row * DIN + perm_in(col)] = v[0]; } };
struct MEpiMix { const float* zs; const float* bco; bf16_t* mixed;
    __device__ __forceinline__ void operator()(int row, int col, const float* v) const {
        const float sa = fsigmoid(zs[(size_t)row * DIN + 3584 + col]), sc = fsigmoid(zs[(size_t)row * DIN + 4608 + col]);
        const float r = sa * v[0] + sc * (v[1] + bco[col]);
        mixed[(size_t)row * DM + col] = (bf16_t)(cvt_pk_bf16(r, 0.f) & 0xffffu); } };
struct MEpiRes { const float* base; float* out; bf16_t* ob; float* rss;
    __device__ __forceinline__ void operator()(int row, int col, const float* v) const {
        const float h = base[(size_t)row * DM + col] + v[0]; out[(size_t)row * DM + col] = h; ob[(size_t)row * DM + col] = (bf16_t)(cvt_pk_bf16(h, 0.f) & 0xffffu);
        const float s = half_sum32(h * h); if ((col & 31) == 0) rss[(size_t)row * 32 + (col >> 5)] = s; } };
struct MEpiFF1 { const float* rss; bf16_t* f;
    __device__ __forceinline__ void operator()(int row, int col, const float* v) const {
        const float t = fmaxf(v[0] * row_rs32(rss, row), 0.f); f[(size_t)row * DFF + col] = (bf16_t)(cvt_pk_bf16(t * t, 0.f) & 0xffffu); } };
struct MEpiGate { const float* rss; float* y;
    __device__ __forceinline__ void operator()(int row, int col, const float* v) const {
        const float g = fsigmoid(v[1] * row_rs32(rss, row)); y[(size_t)row * DM + col] += g * v[0]; } };

constexpr size_t MiB = 1u << 20;
constexpr size_t WS_CTL = 0;
constexpr size_t WS_WIN = 2 * MiB, WS_WOC = 14 * MiB, WS_WOUT = 18 * MiB, WS_WFF1 = 20 * MiB, WS_WFF2 = 28 * MiB, WS_WPG = 36 * MiB, WS_WPLE = 118 * MiB;
constexpr size_t WS_ROPE = 39 * MiB, WS_XINV = 41 * MiB + 512 * 1024, WS_RSS1 = 65536, WS_RSS2 = 65536 + 131072;
constexpr size_t WS_ZS = 46 * MiB, WS_AOYC_S = 49 * MiB, WS_MIX_S = WS_AOYC_S + 512 * 1024, WS_HB_S = WS_MIX_S + 256 * 1024, WS_F_S = 50 * MiB, WS_H2B_S = 51 * MiB,
                 WS_PP_S = WS_H2B_S + 256 * 1024, WS_RSS1_S = WS_PP_S + 512 * 1024, WS_RSS2_S = WS_RSS1_S + 16 * 1024;
constexpr size_t WS_U = 52 * MiB;
constexpr size_t WS_PB = 422 * MiB;
constexpr size_t WS_BIG = 134 * MiB;
constexpr size_t WS_Q = WS_BIG, WS_K = WS_BIG + 64 * MiB, WS_V = WS_BIG + 80 * MiB, WS_A = WS_BIG + 96 * MiB, WS_RR = WS_BIG + 160 * MiB, WS_SGC = WS_BIG + 224 * MiB;
constexpr size_t WS_MIXED = WS_Q;
constexpr size_t WS_F = WS_BIG;
constexpr size_t WS_END = 487 * MiB;
static_assert(WS_RSS2_S + 16 * 1024 <= WS_U && WS_U + (size_t)MT * DM * 2 <= WS_WPLE && WS_WPLE + 2 * MiB <= WS_BIG && WS_PB + (size_t)MT * DM * 2 <= WS_END, "ws map");
constexpr size_t OUT_Y = 0, OUT_YS = (size_t)MP * DM, OUT_NK = OUT_YS + (size_t)NS * DM, OUT_NV = OUT_NK + 4 * 128 * 256, OUT_NC = OUT_NV + 4 * 128 * 256,
                 OUT_NKS = OUT_NC + 4 * 30 * DM, OUT_NVS = OUT_NKS + (size_t)NS * 128 * 256, OUT_NCS = OUT_NVS + (size_t)NS * 128 * 256, OUT_END = OUT_NCS + (size_t)NS * 30 * DM;

constexpr int RING_BYTES = 131072, LDS_BYTES = 147456;

struct Args { const float* in[27]; float* out; unsigned char* ws; int ph_lo, ph_hi; };
typedef const __attribute__((address_space(4))) Args* ArgsP;
__device__ __forceinline__ ArgsP kargs() { ArgsP p = (ArgsP)__builtin_amdgcn_kernarg_segment_ptr(); asm volatile("" : "+s"(p)); return p; }
enum { I_XP = 0, I_XS, I_CK, I_CV, I_SC, I_PP, I_PS, I_LN1, I_WIN, I_BGLU, I_QN, I_KN, I_SINKS, I_WOA, I_CDW, I_CDWB, I_CLNG, I_CLNB, I_WCO, I_BCO, I_WOUT, I_LN2, I_WFF1, I_WFF2, I_LNPLE, I_WPG, I_WPLE };

__device__ __forceinline__ unsigned f2bf(float f) { unsigned u = __float_as_uint(f); return (u + 0x7fffu + ((u >> 16) & 1u)) >> 16; }
__device__ __forceinline__ unsigned pk2(float lo, float hi) { return f2bf(lo) | (f2bf(hi) << 16); }
__device__ __forceinline__ void p0_transpose_item(const float* W, int N, int src_col0, int k0, const float* ksc, bf16_t* WT, int ldk, int dst_row0, int dst_k0, LAS float* scr, int lane) {
    float tv[32];
#pragma unroll
    for (int i = 0; i < 32; ++i) { const int kk = 2 * i + (lane >> 5); tv[i] = __builtin_nontemporal_load(&W[(size_t)(k0 + kk) * N + src_col0 + (lane & 31)]); }
    if (ksc) {
#pragma unroll
        for (int i = 0; i < 32; ++i) tv[i] *= ksc[k0 + 2 * i + (lane >> 5)];
    }
#pragma unroll
    for (int i = 0; i < 32; ++i) scr[(2 * i + (lane >> 5)) * 33 + (lane & 31)] = tv[i];
    asm volatile("s_waitcnt lgkmcnt(0)" ::: "memory");
    const int c = lane & 7;
#pragma unroll
    for (int j = 0; j < 4; ++j) { const int n = (lane >> 3) + 8 * j; const LAS float* s = scr + (8 * c) * 33 + n;
        u32x4 o; o.x = pk2(s[0 * 33], s[1 * 33]); o.y = pk2(s[2 * 33], s[3 * 33]); o.z = pk2(s[4 * 33], s[5 * 33]); o.w = pk2(s[6 * 33], s[7 * 33]);
        *(u32x4*)(WT + (size_t)(dst_row0 + n) * ldk + dst_k0 + k0 + 8 * c) = o; }
    asm volatile("s_waitcnt lgkmcnt(0)" ::: "memory");
}

template <int PART> __device__ __forceinline__ void phase0(LAS unsigned char* lds, int blk, int G) {
    const ArgsP ap = kargs();
    int tid_ = threadIdx.x; asm volatile("" : "+v"(tid_));
    const int tid = tid_, wave = __builtin_amdgcn_readfirstlane(tid >> 6), lane = tid & 63;
    unsigned char* ws = ap->ws;
    LAS float* scr = (LAS float*)(lds + wave * 16384);
    const int gw = blk * 8 + wave, NGW = G * 8;
    bf16_t* Win_t = (bf16_t*)(ws + WS_WIN); bf16_t* Woc_t = (bf16_t*)(ws + WS_WOC); bf16_t* Wout_t = (bf16_t*)(ws + WS_WOUT); bf16_t* Wff1_t = (bf16_t*)(ws + WS_WFF1);
    bf16_t* Wff2_t = (bf16_t*)(ws + WS_WFF2); bf16_t* Wpg_t = (bf16_t*)(ws + WS_WPG); bf16_t* Wple_t = (bf16_t*)(ws + WS_WPLE);
    constexpr int NITEMS = 2816 + 512 * 3 + 2048 * 2 + 512 + 128;
    constexpr int IT_LO = PART == 0 ? 0 : 2816, IT_HI = PART == 0 ? 2816 : NITEMS;
    for (int it0 = IT_LO + gw; it0 < IT_HI; it0 += NGW) {
        int it = it0;
        if (it < 2816) { const int kb = it / 176, nb = it % 176; p0_transpose_item(ap->in[I_WIN], DIN, perm_in(32 * nb), 64 * kb, ap->in[I_LN1], Win_t, DM, 32 * nb, 0, scr, lane); continue; } it -= 2816;
        if (it < 512) { const int kb = it >> 5, nb = it & 31; p0_transpose_item(ap->in[I_WOA], DM, 32 * nb, 64 * kb, nullptr, Woc_t, 2048, 32 * nb, 0, scr, lane); continue; } it -= 512;
        if (it < 512) { const int kb = it >> 5, nb = it & 31; p0_transpose_item(ap->in[I_WCO], DM, 32 * nb, 64 * kb, nullptr, Woc_t, 2048, 32 * nb, 1024, scr, lane); continue; } it -= 512;
        if (it < 512) { const int kb = it >> 5, nb = it & 31; p0_transpose_item(ap->in[I_WOUT], DM, 32 * nb, 64 * kb, nullptr, Wout_t, DM, 32 * nb, 0, scr, lane); continue; } it -= 512;
        if (it < 2048) { const int kb = it >> 7, nb = it & 127; p0_transpose_item(ap->in[I_WFF1], DFF, 32 * nb, 64 * kb, ap->in[I_LN2], Wff1_t, DM, 32 * nb, 0, scr, lane); continue; } it -= 2048;
        if (it < 2048) { const int kb = it >> 5, nb = it & 31; p0_transpose_item(ap->in[I_WFF2], DM, 32 * nb, 64 * kb, nullptr, Wff2_t, DFF, 32 * nb, 0, scr, lane); continue; } it -= 2048;
        if (it < 512) { const int kb = it >> 5, nb = it & 31; p0_transpose_item(ap->in[I_WPG], DM, 32 * nb, 64 * kb, ap->in[I_LNPLE], Wpg_t, DM, 32 * nb, 0, scr, lane); continue; } it -= 512;
        { const int kb = it >> 5, nb = it & 31; p0_transpose_item(ap->in[I_WPLE], DM, 32 * nb, 64 * kb, nullptr, Wple_t, DM, 32 * nb, 0, scr, lane); }
    }
    bf16_t* U = (bf16_t*)(ws + WS_U);
    if constexpr (PART == 0)
    for (int m0 = gw * 4; m0 < MT; m0 += NGW * 4) {
        f32x4 v[4][4];
#pragma unroll
        for (int r = 0; r < 4; ++r) { const int m = m0 + r; const f32x4* xr = (const f32x4*)(m < MP ? ap->in[I_XP] + (size_t)m * DM : ap->in[I_XS] + (size_t)(m - MP) * DM);
#pragma unroll
            for (int j = 0; j < 4; ++j) v[r][j] = __builtin_nontemporal_load(&xr[lane + 64 * j]); }
#pragma unroll
        for (int r = 0; r < 4; ++r) { const int m = m0 + r; float ss = 0.f;
#pragma unroll
            for (int j = 0; j < 4; ++j) ss += (v[r][j][0] * v[r][j][0] + v[r][j][1] * v[r][j][1]) + (v[r][j][2] * v[r][j][2] + v[r][j][3] * v[r][j][3]);
            const float ms = wave_sum(ss) * (1.f / DM) + EPS; const float rs = rsqrtf(ms);
            if (lane == 0) ((float*)(ws + WS_XINV))[m] = sqrtf(ms);
            u32x2* o = (u32x2*)(U + (size_t)m * DM);
#pragma unroll
            for (int j = 0; j < 4; ++j) { u32x2 w; w.x = pk2(v[r][j][0] * rs, v[r][j][1] * rs); w.y = pk2(v[r][j][2] * rs, v[r][j][3] * rs); o[lane + 64 * j] = w; } }
    }
    bf16_t* PB = (bf16_t*)(ws + WS_PB);
    if constexpr (PART == 1)
    for (int m0 = gw * 8; m0 < MT; m0 += NGW * 8) {
        f32x4 v[8];
#pragma unroll
        for (int r = 0; r < 8; ++r) { const int m = m0 + r; const f32x4* pr = (const f32x4*)(m < MP ? ap->in[I_PP] + (size_t)m * DPLE : ap->in[I_PS] + (size_t)(m - MP) * DPLE); v[r] = __builtin_nontemporal_load(&pr[lane]); }
#pragma unroll
        for (int r = 0; r < 8; ++r) { u32x2 w; w.x = pk2(v[r][0], v[r][1]); w.y = pk2(v[r][2], v[r][3]); ((u32x2*)(PB + (size_t)(m0 + r) * DM))[lane] = w; }
    }
    f32x2* rope = (f32x2*)(ws + WS_ROPE);
    if constexpr (PART == 0)
    for (int idx = blk * 512 + tid; idx < 8193 * 32; idx += G * 512) {
        const int pr = idx >> 5, f = idx & 31; const int pos = pr < SEQ ? pr : 16384;
        double invd = 1.0; for (int i = 0; i < f; ++i) invd *= 0.74989420933245582730;
        const float invf = (float)invd; const float ang = (float)pos * invf;
        const double x = (double)ang; const double n = rint(x * 0.63661977236758134308);
        double r = fma(-n, 1.57079632679489655800, x); r = fma(-n, 6.12323399573676603587e-17, r);
        const double r2 = r * r;
        const double sp = r * (1.0 + r2 * (-1.0 / 6 + r2 * (1.0 / 120 + r2 * (-1.0 / 5040 + r2 * (1.0 / 362880 + r2 * (-1.0 / 39916800 + r2 * (1.0 / 6227020800.0)))))));
        const double cp = 1.0 + r2 * (-0.5 + r2 * (1.0 / 24 + r2 * (-1.0 / 720 + r2 * (1.0 / 40320 + r2 * (-1.0 / 3628800 + r2 * (1.0 / 479001600 + r2 * (-1.0 / 87178291200.0)))))));
        const int q = ((int)n) & 3;
        const double c = (q == 0) ? cp : (q == 1) ? -sp : (q == 2) ? -cp : sp;
        const double s = (q == 0) ? sp : (q == 1) ? cp : (q == 2) ? -sp : -cp;
        rope[idx] = (f32x2){(float)c, (float)s};
    }
}

struct P2Ctx { const bf16_t *q, *k, *v, *a; bf16_t* aoyc; const float* sinks; };

typedef short v4i16_t __attribute__((ext_vector_type(4)));
struct AttnPre { u32x4 k[3], v[3]; bf16x8 q[4]; };
__device__ __forceinline__ void attn_load(const P2Ctx& c, int unit, AttnPre& P, int tid, int wave, int lane) {
    const int kvh = unit & 3, qblk = (unit >> 2) & 127, b = unit >> 9; const int t0 = qblk * 64;
#pragma unroll
    for (int it = 0; it < 3; ++it) {
        const int ci = tid + it * 512; const int key = ci >> 3, ch = ci & 7; const int t = t0 - 128 + key;
        P.k[it] = (u32x4){0u, 0u, 0u, 0u}; P.v[it] = (u32x4){0u, 0u, 0u, 0u};
        if (t >= 0) { const size_t ro = (size_t)(b * SEQ + t) * 256 + kvh * 64 + ch * 8; P.k[it] = __builtin_nontemporal_load((const u32x4*)(c.k + ro)); P.v[it] = __builtin_nontemporal_load((const u32x4*)(c.v + ro)); }
    }
    const int g = wave & 3, s = wave >> 2, head = kvh * 4 + g, q = lane & 31, hi = lane >> 5;
    const size_t qrow = (size_t)b * SEQ + t0 + 32 * s + q;
#pragma unroll
    for (int ks = 0; ks < 4; ++ks) P.q[ks] = __builtin_nontemporal_load((const bf16x8*)(c.q + qrow * DM + head * 64 + ks * 16 + hi * 8));
}
__device__ __forceinline__ void attn_stage(const AttnPre& P, LAS unsigned char* buf, int tid) {
    LAS unsigned char* Ks = buf; LAS unsigned char* Vt = buf + 27648;
#pragma unroll
    for (int it = 0; it < 3; ++it) {
        const int ci = tid + it * 512; const int key = ci >> 3, ch = ci & 7;
        *(LAS u32x4*)(Ks + key * 144 + ch * 16) = P.k[it];
        *(LAS u32x4*)(Vt + key * 144 + ch * 16) = P.v[it];
    }
}
__device__ __forceinline__ void attn_compute(const P2Ctx& c, int unit, const bf16x8 (&qf)[4], const LAS unsigned char* buf, int wave, int lane) {
    const int kvh = unit & 3, qblk = (unit >> 2) & 127, b = unit >> 9; const int t0 = qblk * 64;
    const LAS unsigned char* Ks = buf; const LAS unsigned char* Vt = buf + 27648;
    const int g = wave & 3, s = wave >> 2, head = kvh * 4 + g, q = lane & 31, hi = lane >> 5;
    const size_t qrow = (size_t)b * SEQ + t0 + 32 * s + q;
    f32x16 sc[5];
#pragma unroll
    for (int kt = 0; kt < 5; ++kt) {
        sc[kt] = (f32x16){0.f, 0.f, 0.f, 0.f, 0.f, 0.f, 0.f, 0.f, 0.f, 0.f, 0.f, 0.f, 0.f, 0.f, 0.f, 0.f};
#pragma unroll
        for (int ks = 0; ks < 4; ++ks) { const bf16x8 kf = *(const LAS bf16x8*)(Ks + (32 * s + 32 * kt + q) * 144 + ks * 32 + hi * 16); sc[kt] = __builtin_amdgcn_mfma_f32_32x32x16_bf16(kf, qf[ks], sc[kt], 0, 0, 0); }
    }
#pragma unroll
    for (int r = 0; r < 16; ++r) { const int i = crow(r, hi); if (i <= q) sc[0][r] = NEGBIG; if (i > q) sc[4][r] = NEGBIG; }
    if (t0 < 128) {
#pragma unroll
        for (int kt = 0; kt < 5; ++kt)
#pragma unroll
            for (int r = 0; r < 16; ++r) { const int tk = t0 - 128 + 32 * s + 32 * kt + crow(r, hi); if (tk < 0) sc[kt][r] = NEGBIG; }
    }
    const float sink2 = c.sinks[head] * LOG2E;
    float mx = sink2;
#pragma unroll
    for (int kt = 0; kt < 5; ++kt)
#pragma unroll
        for (int r = 0; r < 16; ++r) mx = fmaxf(mx, sc[kt][r]);
    mx = fmaxf(mx, __shfl_xor(mx, 32));
    float l = 0.f;
#pragma unroll
    for (int kt = 0; kt < 5; ++kt)
#pragma unroll
        for (int r = 0; r < 16; ++r) { const float p = __builtin_amdgcn_exp2f(sc[kt][r] - mx); sc[kt][r] = p; l += p; }
    l += __shfl_xor(l, 32); l += __builtin_amdgcn_exp2f(sink2 - mx);
    f32x16 o[2];
    o[0] = (f32x16){0.f, 0.f, 0.f, 0.f, 0.f, 0.f, 0.f, 0.f, 0.f, 0.f, 0.f, 0.f, 0.f, 0.f, 0.f, 0.f}; o[1] = o[0];
#pragma unroll
    for (int kt = 0; kt < 5; ++kt)
#pragma unroll
        for (int ks2 = 0; ks2 < 2; ++ks2) {
            u32x4 pw; pw.x = cvt_pk_bf16(sc[kt][8 * ks2 + 0], sc[kt][8 * ks2 + 1]); pw.y = cvt_pk_bf16(sc[kt][8 * ks2 + 2], sc[kt][8 * ks2 + 3]);
            pw.z = cvt_pk_bf16(sc[kt][8 * ks2 + 4], sc[kt][8 * ks2 + 5]); pw.w = cvt_pk_bf16(sc[kt][8 * ks2 + 6], sc[kt][8 * ks2 + 7]);
            const bf16x8 pb = __builtin_bit_cast(bf16x8, pw);
            const int kk0 = 32 * s + 32 * kt + 16 * ks2 + 4 * hi;
#pragma unroll
            for (int dt = 0; dt < 2; ++dt) {
                const LAS unsigned char* vp = Vt + (kk0 + ((lane & 15) >> 2)) * 144 + (32 * dt + 16 * ((lane >> 4) & 1) + 4 * (lane & 3)) * 2;
                const v4i16_t lo = __builtin_amdgcn_ds_read_tr16_b64_v4i16((LAS v4i16_t*)vp), h2 = __builtin_amdgcn_ds_read_tr16_b64_v4i16((LAS v4i16_t*)(vp + 8 * 144));
                const bf16x8 vw = {lo[0], lo[1], lo[2], lo[3], h2[0], h2[1], h2[2], h2[3]};
                o[dt] = __builtin_amdgcn_mfma_f32_32x32x16_bf16(vw, pb, o[dt], 0, 0, 0);
            }
        }
    const float inv = 1.f / l;
    bf16_t* op = c.aoyc + qrow * 2048 + head * 64;
#pragma unroll
    for (int dt = 0; dt < 2; ++dt)
#pragma unroll
        for (int j = 0; j < 4; ++j) { u32x2 w; w.x = cvt_pk_bf16(o[dt][4 * j] * inv, o[dt][4 * j + 1] * inv); w.y = cvt_pk_bf16(o[dt][4 * j + 2] * inv, o[dt][4 * j + 3] * inv);
            *(u32x2*)(op + 32 * dt + 8 * j + 4 * hi) = w; }
}

__device__ __forceinline__ void p2_conv(LAS unsigned char* lds, int blk, int G) {
    const ArgsP ap = kargs();
    int tid_ = threadIdx.x; asm volatile("" : "+v"(tid_));
    const int tid = tid_, wave = __builtin_amdgcn_readfirstlane(tid >> 6), lane = tid & 63;
    unsigned char* ws = ap->ws;
    P2Ctx c; c.q = (const bf16_t*)(ws + WS_Q); c.k = (const bf16_t*)(ws + WS_K); c.v = (const bf16_t*)(ws + WS_V); c.a = (const bf16_t*)(ws + WS_A);
    c.aoyc = (bf16_t*)(ap->out + OUT_Y); c.sinks = ap->in[I_SINKS];
    const float* zs = (const float*)(ws + WS_ZS); bf16_t* aoyc_s = (bf16_t*)(ws + WS_AOYC_S);
    const f32x2* rope = (const f32x2*)(ws + WS_ROPE);
    {
        const int c0 = 2 * tid;
        f32x2 w[31];
#pragma unroll
        for (int j = 0; j < 31; ++j) w[j] = *(const f32x2*)(ap->in[I_CDW] + (size_t)j * DM + c0);
        const f32x2 dwb = *(const f32x2*)(ap->in[I_CDWB] + c0), lg = *(const f32x2*)(ap->in[I_CLNG] + c0), lb = *(const f32x2*)(ap->in[I_CLNB] + c0);
        LAS float* red = (LAS float*)lds;
        LAS float* stat = (LAS float*)(lds + 2048);
        {
            constexpr int NCU = NBATCH * (SEQ / 16);
            unsigned av[46]; int par = 0;
            if (blk < NCU) { const int b = blk >> 9, t0 = (blk & 511) * 16;
#pragma unroll
                for (int r = 0; r < 46; ++r) { const int t = t0 - 30 + r; av[r] = (t >= 0) ? *(const unsigned*)(c.a + (size_t)(b * SEQ + t) * DM + c0) : 0u; } }
            for (int unit = blk; unit < NCU; unit += G) {
                const int b = unit >> 9, t0 = (unit & 511) * 16;
                LAS float* redp = red + par * 256; LAS float* statp = stat + par * 32;
                const int cid = unit * 512 + tid;
                f32x4 cc4 = {0.f, 0.f, 0.f, 0.f}; size_t cdst = 0; bool cok = false;
                if (cid < NS * 29 * 256) { const int sb = cid / (29 * 256), rem = cid - sb * (29 * 256); const int row = rem >> 8, ch = rem & 255; cok = true;
                    cdst = ((size_t)(sb * 30 + row) * 256 + ch) * 4; cc4 = __builtin_nontemporal_load((const f32x4*)(ap->in[I_SC] + ((size_t)(sb * 30 + row + 1) * 256 + ch) * 4)); }
                f32x2 y[16];
                {
                    f32x2 au[46];
#pragma unroll
                    for (int r = 0; r < 46; ++r) au[r] = (f32x2){bf_lo(av[r]), bf_hi(av[r])};
#pragma unroll
                    for (int i = 0; i < 16; ++i) y[i] = dwb;
#pragma unroll
                    for (int ig = 0; ig < 4; ++ig)
#pragma unroll
                        for (int j = 0; j < 31; ++j)
#pragma unroll
                            for (int i = 4 * ig; i < 4 * ig + 4; ++i) y[i] = pk_fma(au[i + j], w[j], y[i]);
                }
                if (unit + G < NCU) { const int nu = unit + G; const int nb = nu >> 9, nt0 = (nu & 511) * 16;
#pragma unroll
                    for (int r = 0; r < 46; ++r) { const int t = nt0 - 30 + r; av[r] = (t >= 0) ? *(const unsigned*)(c.a + (size_t)(nb * SEQ + t) * DM + c0) : 0u; } }
                {
                    float rv[32];
#pragma unroll
                    for (int i = 0; i < 16; ++i) { rv[i] = y[i][0] + y[i][1]; rv[16 + i] = y[i][0] * y[i][0] + y[i][1] * y[i][1]; }
#pragma unroll
                    for (int k = 0; k < 16; ++k) { const auto r = __builtin_amdgcn_permlane32_swap(__float_as_uint(rv[k]), __float_as_uint(rv[k + 16]), false, false); rv[k] = __uint_as_float(r[0]) + __uint_as_float(r[1]); }
#pragma unroll
                    for (int k = 0; k < 8; ++k) { const auto r = __builtin_amdgcn_permlane16_swap(__float_as_uint(rv[k]), __float_as_uint(rv[k + 8]), false, false); rv[k] = __uint_as_float(r[0]) + __uint_as_float(r[1]); }
                    const bool b3 = (lane & 8) != 0, b2 = (lane & 4) != 0, b1 = (lane & 2) != 0;
#pragma unroll
                    for (int k = 0; k < 4; ++k) { const float send = b3 ? rv[k] : rv[k + 4], keep = b3 ? rv[k + 4] : rv[k]; rv[k] = keep + dpp_all<0x140>(send); }
#pragma unroll
                    for (int k = 0; k < 2; ++k) { const float send = b2 ? rv[k] : rv[k + 2], keep = b2 ? rv[k + 2] : rv[k]; rv[k] = keep + dpp_all<0x141>(send); }
                    { const float send = b1 ? rv[0] : rv[1], keep = b1 ? rv[1] : rv[0]; rv[0] = keep + dpp_all<0x4E>(send); }
                    rv[0] += dpp_all<0xB1>(rv[0]);
                    if ((lane & 1) == 0) { const int v = lane >> 1; redp[(wave * 16 + (v & 15)) * 2 + (v >> 4)] = rv[0]; }
                }
                __syncthreads();
                if (tid < 16) { float s = 0.f, qq = 0.f;
#pragma unroll
                    for (int w8 = 0; w8 < 8; ++w8) { s += redp[(w8 * 16 + tid) * 2]; qq += redp[(w8 * 16 + tid) * 2 + 1]; }
                    const float mu = s * (1.f / DM); const float var = fmaxf(qq * (1.f / DM) - mu * mu, 0.f);
                    statp[tid * 2] = mu; statp[tid * 2 + 1] = rsqrtf(var + EPS); }
                __syncthreads();
#pragma unroll
                for (int i = 0; i < 16; ++i) { const float mu = statp[i * 2], rstd = statp[i * 2 + 1];
                    const float y0 = (y[i][0] - mu) * rstd * lg[0] + lb[0], y1 = (y[i][1] - mu) * rstd * lg[1] + lb[1];
                    *(unsigned*)(c.aoyc + (size_t)(b * SEQ + t0 + i) * 2048 + DM + c0) = cvt_pk_bf16(y0 * fsigmoid(y0), y1 * fsigmoid(y1)); }
                if (cok) *(f32x4*)(ap->out + OUT_NCS + cdst) = cc4;
                par ^= 1;
            }
            __syncthreads();
        }
        for (int b = blk; b < NS; b += G) {
            const float* st = ap->in[I_SC] + (size_t)b * 30 * DM + c0; float* nc = ap->out + OUT_NCS + (size_t)b * 30 * DM + c0;
            f32x2 acc = dwb;
#pragma unroll
            for (int j = 0; j < 30; ++j) { const f32x2 h = *(const f32x2*)(st + (size_t)j * DM); acc[0] += h[0] * w[j][0]; acc[1] += h[1] * w[j][1]; }
            const float* z = zs + (size_t)b * DIN; const float* bg = ap->in[I_BGLU];
            f32x2 an;
            an[0] = (z[1536 + c0] + bg[c0]) * fsigmoid(z[2560 + c0] + bg[DM + c0]); an[1] = (z[1536 + c0 + 1] + bg[c0 + 1]) * fsigmoid(z[2560 + c0 + 1] + bg[DM + c0 + 1]);
            *(f32x2*)(nc + (size_t)29 * DM) = an;
            acc[0] += an[0] * w[30][0]; acc[1] += an[1] * w[30][1];
            const float s = wave_sum(acc[0] + acc[1]), qq = wave_sum(acc[0] * acc[0] + acc[1] * acc[1]);
            if (lane == 0) { red[wave * 2] = s; red[wave * 2 + 1] = qq; }
            __syncthreads();
            float S = 0.f, Q = 0.f;
#pragma unroll
            for (int w8 = 0; w8 < 8; ++w8) { S += red[w8 * 2]; Q += red[w8 * 2 + 1]; }
            const float mu = S * (1.f / DM); const float rstd = rsqrtf(fmaxf(Q * (1.f / DM) - mu * mu, 0.f) + EPS);
            const float y0 = (acc[0] - mu) * rstd * lg[0] + lb[0], y1 = (acc[1] - mu) * rstd * lg[1] + lb[1];
            *(unsigned*)(aoyc_s + (size_t)b * 2048 + DM + c0) = cvt_pk_bf16(y0 * fsigmoid(y0), y1 * fsigmoid(y1));
            __syncthreads();
        }
    }
}

__device__ __forceinline__ void p2_attn(LAS unsigned char* lds, int blk, int G) {
    const ArgsP ap = kargs();
    int tid_ = threadIdx.x; asm volatile("" : "+v"(tid_));
    const int tid = tid_, wave = __builtin_amdgcn_readfirstlane(tid >> 6), lane = tid & 63;
    unsigned char* ws = ap->ws;
    P2Ctx c; c.q = (const bf16_t*)(ws + WS_Q); c.k = (const bf16_t*)(ws + WS_K); c.v = (const bf16_t*)(ws + WS_V); c.a = (const bf16_t*)(ws + WS_A);
    c.aoyc = (bf16_t*)(ap->out + OUT_Y); c.sinks = ap->in[I_SINKS];
    const float* zs = (const float*)(ws + WS_ZS); bf16_t* aoyc_s = (bf16_t*)(ws + WS_AOYC_S);
    const f32x2* rope = (const f32x2*)(ws + WS_ROPE);
    {
        constexpr int NU = NBATCH * (SEQ / 64) * 4; constexpr int ABUF = 55296;
        AttnPre P; int par = 0;
        if (blk < NU) attn_load(c, blk, P, tid, wave, lane);
        for (int unit = blk; unit < NU; unit += G) {
            LAS unsigned char* buf = lds + par * ABUF;
            attn_stage(P, buf, tid);
            bf16x8 qf[4];
#pragma unroll
            for (int ks = 0; ks < 4; ++ks) qf[ks] = P.q[ks];
            __syncthreads();
            if (unit + G < NU) attn_load(c, unit + G, P, tid, wave, lane);
            attn_compute(c, unit, qf, buf, wave, lane);
            par ^= 1;
        }
        __syncthreads();
    }
    {
        LAS float* Kf = (LAS float*)lds;
        LAS float* Vf = (LAS float*)(lds + 33280);
        LAS float* qs = (LAS float*)(lds + 66560);
        LAS float* scs = (LAS float*)(lds + 67584);
        float* nk = ap->out + OUT_NKS; float* nv = ap->out + OUT_NVS;
        for (int item = blk; item < NS * 4; item += G) {
            const int b = item >> 2, kvh = item & 3;
            const float* z = zs + (size_t)b * DIN;
            if (wave < 5) {
                const int d = lane; const bool isq = wave < 4;
                const float val = isq ? z[(kvh * 4 + wave) * 64 + d] : z[1024 + kvh * 64 + d];
                const float rs = rsqrtf(wave_sum(val * val) * (1.f / 64.f) + EPS);
                const float xn = val * rs * (isq ? ap->in[I_QN][d] : ap->in[I_KN][d]);
                const float other = __shfl_xor(xn, 32);
                const f32x2 cs = rope[(size_t)SEQ * 32 + (d & 31)];
                const float o = (d < 32) ? (xn * cs[0] - other * cs[1]) : (xn * cs[0] + other * cs[1]);
                if (isq) qs[wave * 64 + d] = o * QSCALE;
                else { Kf[127 * 65 + d] = o; nk[((size_t)(b * 128 + 127) * 4 + kvh) * 64 + d] = o; }
            } else if (wave == 5) {
                const float val = z[1280 + kvh * 64 + lane]; Vf[127 * 65 + lane] = val; nv[((size_t)(b * 128 + 127) * 4 + kvh) * 64 + lane] = val;
            }
            for (int idx = tid; idx < 127 * 16; idx += 512) {
                const int row = idx >> 4, c4 = idx & 15;
                const f32x4 kv4 = __builtin_nontemporal_load((const f32x4*)(ap->in[I_CK] + ((size_t)(b * 128 + row + 1) * 4 + kvh) * 64 + c4 * 4));
                const f32x4 vv4 = __builtin_nontemporal_load((const f32x4*)(ap->in[I_CV] + ((size_t)(b * 128 + row + 1) * 4 + kvh) * 64 + c4 * 4));
#pragma unroll
                for (int e = 0; e < 4; ++e) { Kf[row * 65 + c4 * 4 + e] = kv4[e]; Vf[row * 65 + c4 * 4 + e] = vv4[e]; }
                *(f32x4*)(nk + ((size_t)(b * 128 + row) * 4 + kvh) * 64 + c4 * 4) = kv4; *(f32x4*)(nv + ((size_t)(b * 128 + row) * 4 + kvh) * 64 + c4 * 4) = vv4;
            }
            __syncthreads();
            { const int j = tid >> 2, h = tid & 3; float s = 0.f;
#pragma unroll 16
              for (int d = 0; d < 64; ++d) s += Kf[j * 65 + d] * qs[h * 64 + d];
              scs[h * 128 + j] = s; }
            __syncthreads();
            if (wave < 4) { const float sink2 = ap->in[I_SINKS][kvh * 4 + wave] * LOG2E;
                const float v0 = scs[wave * 128 + lane], v1 = scs[wave * 128 + 64 + lane];
                const float mx = fmaxf(sink2, wave_max(fmaxf(v0, v1)));
                const float p0 = __builtin_amdgcn_exp2f(v0 - mx), p1 = __builtin_amdgcn_exp2f(v1 - mx);
                const float l = wave_sum(p0 + p1) + __builtin_amdgcn_exp2f(sink2 - mx); const float inv = 1.f / l;
                scs[wave * 128 + lane] = p0 * inv; scs[wave * 128 + 64 + lane] = p1 * inv; }
            __syncthreads();
            if (tid < 256) { const int h = tid >> 6, d = tid & 63; float o = 0.f;
#pragma unroll 16
                for (int j = 0; j < 128; ++j) o += scs[h * 128 + j] * Vf[j * 65 + d];
                aoyc_s[(size_t)b * 2048 + (kvh * 4 + h) * 64 + d] = (bf16_t)f2bf(o); }
            __syncthreads();
        }
    }
}


#define XB_TMO      128
#define XB_XCNT(j)  (256  + 64 * (j))
#define XB_XSUB(j)  (1280 + 64 * (j))
#define XB_XGEN(j)  (2304 + 64 * (j))
#define XB_TOP      3328
#define XB_TOPGEN   3392
#define XCD_BAR_WORDS 3456
#define XB_SPIN_CAP (1u << 18)
__device__ __forceinline__ unsigned xb_ld(unsigned* p)              { return __hip_atomic_load(p, __ATOMIC_RELAXED, __HIP_MEMORY_SCOPE_AGENT); }
__device__ __forceinline__ unsigned xb_add(unsigned* p, unsigned v) { return __hip_atomic_fetch_add(p, v, __ATOMIC_RELAXED, __HIP_MEMORY_SCOPE_AGENT); }
__device__ __forceinline__ unsigned xb_xcc_id() { return (unsigned)__builtin_amdgcn_s_getreg((3 << 11) | 20) & 0xFu; }
#define XB_SPIN(cond, bar) do { unsigned _sp = 0; while (cond) { __builtin_amdgcn_s_sleep(12); \
    if ((++_sp & 255u) == 0u) { if (xb_ld(&(bar)[XB_TMO])) break; if (_sp > XB_SPIN_CAP) { atomicAdd(&(bar)[XB_TMO], 1u); break; } } } } while (0)
struct XcdBarrier { unsigned* bar; unsigned x; volatile LAS unsigned* st; };
__device__ __forceinline__ XcdBarrier xcd_barrier_post(unsigned* bar, volatile LAS unsigned* st) {
    XcdBarrier b; b.bar = bar; b.x = xb_xcc_id(); b.st = st;
    if (threadIdx.x == 0) (void)xb_add(&bar[XB_XCNT(b.x)], 1u);
    return b;
}
__device__ __forceinline__ void xcd_barrier_complete(unsigned* bar, unsigned x, unsigned& nloc, unsigned& nx) {
    const unsigned G = gridDim.x * gridDim.y * gridDim.z;
    unsigned sum, cnt, mine, sp = 0u;
    for (;;) {
        sum = 0u; cnt = 0u; mine = 0u;
#pragma unroll
        for (unsigned j = 0; j < 16; ++j) { const unsigned c = xb_ld(&bar[XB_XCNT(j)]); sum += c; cnt += (c > 0u) ? 1u : 0u; mine = (j == x) ? c : mine; }
        if (sum == G) break;
        __builtin_amdgcn_s_sleep(1);
        if ((++sp & 255u) == 0u) { if (xb_ld(&bar[XB_TMO])) break; if (sp > XB_SPIN_CAP) { atomicAdd(&bar[XB_TMO], 1u); break; } }
    }
    nloc = mine > 0u ? mine : 1u; nx = cnt > 0u ? cnt : 1u;
}
__device__ __forceinline__ void xcd_barrier(const XcdBarrier& b) {
    asm volatile("s_waitcnt vmcnt(0)" ::: "memory");
    __syncthreads();
    if (threadIdx.x == 0) {
        unsigned* bar = b.bar;
        __builtin_amdgcn_s_waitcnt(0);
        unsigned nloc = b.st[0], nx = b.st[1];
        if (nloc == 0u) { xcd_barrier_complete(bar, b.x, nloc, nx); b.st[0] = nloc; b.st[1] = nx; }
        const unsigned old = xb_add(&bar[XB_XSUB(b.x)], 1u);
        const unsigned gen = old / nloc;
        if (old + 1u == (gen + 1u) * nloc) {
            __builtin_amdgcn_fence(__ATOMIC_RELEASE, "agent");
            asm volatile("s_waitcnt vmcnt(0)" ::: "memory");
            const unsigned og = xb_add(&bar[XB_TOP], 1u);
            const unsigned tg = og / nx;
            if (og + 1u == (tg + 1u) * nx) xb_add(&bar[XB_TOPGEN], 1u);
            else XB_SPIN(xb_ld(&bar[XB_TOPGEN]) == tg, bar);
            __builtin_amdgcn_fence(__ATOMIC_ACQUIRE, "agent");
            xb_add(&bar[XB_XGEN(b.x)], 1u);
            asm volatile("s_waitcnt vmcnt(0)" ::: "memory");
        } else {
            XB_SPIN(xb_ld(&bar[XB_XGEN(b.x)]) == gen, bar);
            __builtin_amdgcn_fence(__ATOMIC_ACQUIRE, "agent");
            asm volatile("s_waitcnt vmcnt(0)" ::: "memory");
        }
    }
    __syncthreads();
}
constexpr int CW_BAR = 4096;
constexpr size_t CTL_ZERO_BYTES = 65536 + 2 * 131072;
constexpr int MISC_OFF = RING_BYTES + 320;

__global__ void __launch_bounds__(512, 2) fwd(Args args) {
    extern __shared__ __attribute__((aligned(16))) unsigned char lds_raw[];
    LAS unsigned char* lds = (LAS unsigned char*)lds_raw;
    const int blk = blockIdx.x, G = gridDim.x;
#ifndef REPMASK
#define REPMASK 0
#endif
#define REP(k) for (int rep_ = 0; rep_ < 1 + ((REPMASK >> (k)) & 1); ++rep_)
#define IN(k) true
#define SEAM(k) do { XcdBarrier bar_; bar_.bar = (unsigned*)(kargs()->ws + WS_CTL) + CW_BAR; bar_.x = xb_xcc_id(); bar_.st = (volatile LAS unsigned*)(lds + MISC_OFF) + 8; xcd_barrier(bar_); } while (0)
    volatile LAS unsigned* MISC = (volatile LAS unsigned*)(lds + MISC_OFF);
    if (threadIdx.x < 32) MISC[threadIdx.x] = 0u;
    __syncthreads();
    (void)xcd_barrier_post((unsigned*)(kargs()->ws + WS_CTL) + CW_BAR, MISC + 8);
#define VB_ ((blk & 1) ? (blk >> 1) : ((G + 1) >> 1) + (blk >> 1))
#define mb_pre ((blk & 1) ? VB_ : (1 << 30))
#define mb_post ((blk & 1) ? (1 << 30) : VB_)
    if (IN(0)) REP(0) phase0<0>(lds, blk, G);
    SEAM(0);
    if (IN(1)) REP(1) {
        const ArgsP ap = kargs(); unsigned char* ws = ap->ws; bf16_t* U = (bf16_t*)(ws + WS_U);
        pg8::Gemm g{U, (const bf16_t*)(ws + WS_WIN), DM, DM, MP, DIN, DM}; pg8::StaticOrder S; S.init(MP, DIN, G, blk);
        EpiIn E; E.q = (bf16_t*)(ws + WS_Q); E.k = (bf16_t*)(ws + WS_K); E.v = (bf16_t*)(ws + WS_V); E.a = (bf16_t*)(ws + WS_A); E.gates = (unsigned short*)(ws + WS_RR);
        E.qn = ap->in[I_QN]; E.kn = ap->in[I_KN]; E.bglu = ap->in[I_BGLU]; E.rope = (const f32x2*)(ws + WS_ROPE);
        E.out_nk = ap->out + OUT_NK; E.out_nv = ap->out + OUT_NV; E.out_nc = ap->out + OUT_NC;
        MiniPart p{U + (size_t)MP * DM, DM, (const bf16_t*)(ws + WS_WIN), DM, DM}; MEpiZ ME{(float*)(ws + WS_ZS)};
        const int nj = blk < 4 * (DIN >> 5) ? (4 * (DIN >> 5) - blk + G - 1) / G : 0, npre = (nj * (blk & 3) + 1) / 3;
        mini_gemm<1>(lds, p, p, DIN, ME, blk, G, 0, npre);
        pg8::gemm_phase(lds, g, S, E);
        mini_gemm<1>(lds, p, p, DIN, ME, blk, G, npre, nj);
    }
    SEAM(1);
    if (IN(2)) REP(2) { if (blk & 1) p2_attn(lds, blk, G); p2_conv(lds, blk, G); if (!(blk & 1)) p2_attn(lds, blk, G); phase0<1>(lds, blk, G); __syncthreads(); }
    SEAM(2);
    if (IN(3)) REP(3) {
        const ArgsP ap = kargs(); unsigned char* ws = ap->ws; bf16_t* U = (bf16_t*)(ws + WS_U);
        pg8::Gemm g{(const bf16_t*)(ap->out + OUT_Y), (const bf16_t*)(ws + WS_WOC), 2048, 2048, MP, DM, 2048}; pg8::StaticOrder S; S.init(MP, DM, G, blk);
        EpiMix E{(const unsigned short*)(ws + WS_RR), ap->in[I_BCO], (bf16_t*)(ws + WS_MIXED)};
        MiniPart p0{(const bf16_t*)(ws + WS_AOYC_S), 2048, (const bf16_t*)(ws + WS_WOC), 2048, DM};
        MiniPart p1{(const bf16_t*)(ws + WS_AOYC_S) + DM, 2048, (const bf16_t*)(ws + WS_WOC) + DM, 2048, DM};
        MEpiMix ME{(const float*)(ws + WS_ZS), ap->in[I_BCO], (bf16_t*)(ws + WS_MIX_S)};
        mini_gemm<2>(lds, p0, p1, DM, ME, mb_pre, G);
        pg8::gemm_phase(lds, g, S, E);
        mini_gemm<2>(lds, p0, p1, DM, ME, mb_post, G);
    }
    SEAM(3);
    if (IN(4)) REP(4) {
        const ArgsP ap = kargs(); unsigned char* ws = ap->ws; bf16_t* U = (bf16_t*)(ws + WS_U);
        pg8::Gemm g{(const bf16_t*)(ws + WS_MIXED), (const bf16_t*)(ws + WS_WOUT), DM, DM, MP, DM, DM}; pg8::StaticOrder S; S.init(MP, DM, G, blk);
        EpiResB<true> E{U, (float*)(ws + WS_RSS1), (const float*)(ws + WS_XINV), ap->in[I_LN1]};
        MiniPart p{(const bf16_t*)(ws + WS_MIX_S), DM, (const bf16_t*)(ws + WS_WOUT), DM, DM};
        MEpiRes ME{ap->in[I_XS], ap->out + OUT_YS, (bf16_t*)(ws + WS_HB_S), (float*)(ws + WS_RSS1_S)};
        mini_gemm<1>(lds, p, p, DM, ME, mb_pre, G);
        pg8::gemm_phase(lds, g, S, E);
        mini_gemm<1>(lds, p, p, DM, ME, mb_post, G);
    }
    SEAM(4);
    if (IN(5)) REP(5) {
        const ArgsP ap = kargs(); unsigned char* ws = ap->ws; bf16_t* U = (bf16_t*)(ws + WS_U);
        pg8::Gemm g{U, (const bf16_t*)(ws + WS_WFF1), DM, DM, MP, DFF, DM}; pg8::StaticOrder S; S.init(MP, DFF, G, blk);
        EpiFF1 E{(const float*)(ws + WS_RSS1), (bf16_t*)(ws + WS_F)};
        MiniPart p{(const bf16_t*)(ws + WS_HB_S), DM, (const bf16_t*)(ws + WS_WFF1), DM, DM};
        MEpiFF1 ME{(const float*)(ws + WS_RSS1_S), (bf16_t*)(ws + WS_F_S)};
        const int nj = blk < 4 * (DFF >> 5) ? (4 * (DFF >> 5) - blk + G - 1) / G : 0, npre = (nj * (blk & 3) + 1) / 3;
        mini_gemm<1>(lds, p, p, DFF, ME, blk, G, 0, npre);
        pg8::gemm_phase(lds, g, S, E);
        mini_gemm<1>(lds, p, p, DFF, ME, blk, G, npre, nj);
    }
    SEAM(5);
    if (IN(6)) {
        const ArgsP ap = kargs(); unsigned char* ws = ap->ws; bf16_t* U = (bf16_t*)(ws + WS_U);
        pg8::Gemm g{(const bf16_t*)(ws + WS_F), (const bf16_t*)(ws + WS_WFF2), DFF, DFF, MP, DM, DFF}; pg8::StaticOrder S; S.init(MP, DM, G, blk);
        EpiResB<false> E{U, (float*)(ws + WS_RSS2), nullptr, nullptr};
        MiniPart p{(const bf16_t*)(ws + WS_F_S), DFF, (const bf16_t*)(ws + WS_WFF2), DFF, DFF};
        MEpiRes ME{ap->out + OUT_YS, ap->out + OUT_YS, (bf16_t*)(ws + WS_H2B_S), (float*)(ws + WS_RSS2_S)};
        mini_gemm<1>(lds, p, p, DM, ME, mb_pre, G);
        pg8::gemm_phase(lds, g, S, E);
        mini_gemm<1>(lds, p, p, DM, ME, mb_post, G);
    }
    SEAM(6);
    if (IN(7)) {
        const ArgsP ap = kargs(); unsigned char* ws = ap->ws; bf16_t* U = (bf16_t*)(ws + WS_U);
        MiniPart p0{(const bf16_t*)(ws + WS_PB) + (size_t)MP * DM, DM, (const bf16_t*)(ws + WS_WPLE), DM, DPLE};
        MiniPart p1{(const bf16_t*)(ws + WS_H2B_S), DM, (const bf16_t*)(ws + WS_WPG), DM, DM};
        MEpiGate ME{(const float*)(ws + WS_RSS2_S), ap->out + OUT_YS};
        mini_gemm<2>(lds, p0, p1, DM, ME, mb_pre, G);
        { pg8::Gemm g{U, (const bf16_t*)(ws + WS_WPG), DM, DM, MP, DM, DM}, g1{(const bf16_t*)(ws + WS_PB), (const bf16_t*)(ws + WS_WPLE), DM, DM, MP, DM, DPLE};
          pg8::StaticOrder S; S.init(MP, DM, G, blk);
          EpiGate2 E{(const float*)(ws + WS_RSS2), U, ap->out + OUT_Y};
          pg8::gemm_phase<EpiGate2, true>(lds, g, S, E, g1); }
        mini_gemm<2>(lds, p0, p1, DM, ME, mb_post, G);
    }
#undef IN
#undef SEAM
#undef mb_pre
#undef mb_post
#undef VB_
}

extern "C" void kernel_launch(void* const* d_in, const int* in_sizes, int n_in, void* d_out, int out_size, void* d_ws, size_t ws_size, hipStream_t stream) {
    static int grid = 0;
    if (grid == 0) {
        if (n_in != 27 || (size_t)out_size != OUT_END || ws_size < WS_END) { fprintf(stderr, "kernel_launch: unexpected shapes: n_in %d out %d ws %zu (need %zu)\n", n_in, out_size, ws_size, (size_t)WS_END); grid = -1; return; }
        int dev = 0, cus = 0;
        if (hipGetDevice(&dev) != hipSuccess || hipDeviceGetAttribute(&cus, hipDeviceAttributeMultiprocessorCount, dev) != hipSuccess) { grid = -1; return; }
        if (hipFuncSetAttribute((const void*)fwd, hipFuncAttributeMaxDynamicSharedMemorySize, LDS_BYTES) != hipSuccess) { fprintf(stderr, "kernel_launch: hipFuncSetAttribute failed\n"); grid = -1; return; }
        int per_cu = 0;
        if (hipOccupancyMaxActiveBlocksPerMultiprocessor(&per_cu, (const void*)fwd, 512, LDS_BYTES) != hipSuccess || per_cu < 1) { fprintf(stderr, "kernel_launch: occupancy query says %d blocks per CU\n", per_cu); grid = -1; return; }
        grid = cus;
    }
    if (grid < 0) return;
    Args a{};
    for (int i = 0; i < 27; ++i) a.in[i] = (const float*)d_in[i];
    a.out = (float*)d_out; a.ws = (unsigned char*)d_ws;
    a.ph_lo = 0; a.ph_hi = 8;
    if (hipMemsetAsync((char*)d_ws + WS_CTL, 0, CTL_ZERO_BYTES, stream) != hipSuccess) { fprintf(stderr, "kernel_launch: memset failed\n"); return; }
    hipLaunchKernelGGL(fwd, dim3(grid), dim3(512), LDS_BYTES, stream, a);
    hipError_t e = hipPeekAtLastError();
    if (e != hipSuccess) fprintf(stderr, "kernel_launch: launch failed: %s (grid %d)\n", hipGetErrorString(e), grid);
}
```

```cpp
#include <hip/hip_runtime.h>
#include <hip/hip_cooperative_groups.h>
#include <cstdio>
#include <cstdint>
namespace cg = cooperative_groups;

#define LAS __attribute__((address_space(3)))
typedef unsigned short bf16_t;
typedef short bf16x8 __attribute__((ext_vector_type(8)));
typedef float f32x4 __attribute__((ext_vector_type(4)));
typedef float f32x2 __attribute__((ext_vector_type(2)));
typedef float f32x16 __attribute__((ext_vector_type(16)));
typedef unsigned u32x4 __attribute__((ext_vector_type(4)));
typedef unsigned u32x2 __attribute__((ext_vector_type(2)));

constexpr int SEQ = 8192, NBATCH = 4, MP = NBATCH * SEQ, NS = 128, MT = MP + NS, DM = 1024, DIN = 5632, DFF = 4096, DPLE = 256;
constexpr float EPS = 1e-6f, LOG2E = 1.4426950408889634f, QSCALE = 0.125f * 1.4426950408889634f, NEGBIG = -1e30f;

typedef __bf16 bf16x2_t __attribute__((ext_vector_type(2)));
__device__ __forceinline__ unsigned cvt_pk_bf16(float lo, float hi) { const f32x2 v = {lo, hi}; return __builtin_bit_cast(unsigned, __builtin_convertvector(v, bf16x2_t)); }
__device__ __forceinline__ float fsigmoid(float x) { return __builtin_amdgcn_rcpf(1.f + __builtin_amdgcn_exp2f(-LOG2E * x)); }
__device__ __forceinline__ float bf_lo(unsigned w) { return __uint_as_float(w << 16); }
__device__ __forceinline__ float bf_hi(unsigned w) { return __uint_as_float(w & 0xffff0000u); }
__device__ __forceinline__ float wave_sum(float v) {
#pragma unroll
    for (int o = 1; o < 64; o <<= 1) v += __shfl_xor(v, o);
    return v;
}
__device__ __forceinline__ float wave_max(float v) {
#pragma unroll
    for (int o = 1; o < 64; o <<= 1) v = fmaxf(v, __shfl_xor(v, o));
    return v;
}
__device__ __forceinline__ f32x2 pk_fma(f32x2 a, f32x2 b, f32x2 c) { f32x2 d; asm("v_pk_fma_f32 %0, %1, %2, %3" : "=v"(d) : "v"(a), "v"(b), "v"(c)); return d; }
template <int CTRL, int RMASK> __device__ __forceinline__ float dpp_f(float v) { return __int_as_float(__builtin_amdgcn_update_dpp(0, __float_as_int(v), CTRL, RMASK, 0xF, false)); }
template <int CTRL> __device__ __forceinline__ float dpp_all(float v) { return __int_as_float(__builtin_amdgcn_mov_dpp(__float_as_int(v), CTRL, 0xF, 0xF, true)); }
__device__ __forceinline__ float wave_sum_l63(float v) {
    v += dpp_all<0xB1>(v); v += dpp_all<0x4E>(v); v += dpp_all<0x141>(v); v += dpp_all<0x140>(v);
    v += dpp_f<0x142, 0xA>(v); v += dpp_f<0x143, 0xC>(v); return v; }
__host__ __device__ __forceinline__ int perm_in(int n) {
    const int pn = n >> 8, j = n & 255, bj = j >> 7, wc = (j >> 5) & 3, w = j & 31;
    if (pn < 5) return (pn < 4 ? 256 * pn : 1024) + 64 * wc + 32 * bj + w;
    if (pn == 5) return 1280 + j;
    if (pn < 14) return 1536 + 1024 * bj + 128 * (pn - 6) + (j & 127);
    return 3584 + 1024 * bj + 128 * (pn - 14) + (j & 127);
}

namespace pg8 {
constexpr int BM = 256, BK = 64, HALF = 128, HTB = HALF * BK * 2, STAGE_BYTES = 8 * HTB, NXCD = 8, WGM = 4;
__host__ __device__ __forceinline__ int lds_byte(int r, int c) { const int st = (r >> 4) * 2 + (c >> 5), rr = r & 15, cc = c & 31, ob = rr * 64 + cc * 2; return st * 1024 + (ob ^ (((ob >> 9) & 1) << 5)); }
__host__ __device__ __forceinline__ void stage_rc(int b, int& R, int& C) { const int st = b / 1024, sb = b % 1024, swz = sb ^ (((sb >> 9) & 1) << 5); R = (st >> 1) * 16 + swz / 64; C = (st & 1) * 32 + (swz % 64) / 2; }
__host__ __device__ __forceinline__ int perm32(int rho) { const int n = rho >> 4, i = rho & 15; return 8 * (i >> 2) + 4 * n + (i & 3); }

struct Unit { int pm, pn; };
struct Gemm { const bf16_t* A; const bf16_t* Bt; int lda, ldb; int M, N, K; };

struct StaticOrder {
    int nM, nN, nwg, G, c; bool rev = false;
    __host__ __device__ void init(int M, int N, int G_, int c_) { nM = M / BM; nN = N / BM; nwg = nM * nN; G = G_; c = c_; }
    __host__ __device__ bool next(int i, Unit& u) const {
        const long L = (long)i * G + c; if (L >= nwg) return false;
        int wgid = (int)L; { const int q = nwg / NXCD, r = nwg % NXCD, xcd = wgid % NXCD, off = wgid / NXCD; wgid = (xcd < r ? xcd * (q + 1) : r * (q + 1) + (xcd - r) * q) + off; }
        const int nig = WGM * nN, gid = wgid / nig, fm = gid * WGM, gsz = (nM - fm) < WGM ? (nM - fm) : WGM;
        u.pm = fm + ((wgid % nig) % gsz); u.pn = (wgid % nig) / gsz; if (rev) u.pm = nM - 1 - u.pm; return true;
    }
};

template <class Epi, bool DUAL = false>
__device__ __forceinline__ void gemm_phase(LAS unsigned char* lds, const Gemm g, const StaticOrder& S, const Epi& E, const Gemm g1 = Gemm{}) {
    int tid_ = threadIdx.x; asm volatile("" : "+v"(tid_));
    const int tid = tid_, wid = __builtin_amdgcn_readfirstlane(tid >> 6), lane = tid & 63, wr = wid >> 2, wc = wid & 3, fr = lane & 15, fq = lane >> 4;
    unsigned voffA[2], voffB[2];
#pragma unroll
    for (int i = 0; i < 2; ++i) { int R, C; stage_rc(tid * 16 + i * 8192, R, C); const int Rb = (R & ~31) + perm32(R & 31);
        voffA[i] = (unsigned)(R * g.lda + C) * 2u; voffB[i] = (unsigned)(Rb * g.ldb + C) * 2u; }
    const size_t kstep = (size_t)(BK * 2);
    const size_t hsA = (size_t)HALF * g.lda * 2, hsB = (size_t)HALF * g.ldb * 2;
    const size_t tsA = 2 * hsA, tsB = 2 * hsB;
    const unsigned ldsw = (unsigned)wid * 1024u;
    const int aoff = lds_byte(wr * 64 + fr, fq * 8), boff = lds_byte(wc * 32 + fr, fq * 8);
#define PG8_SA(b, h) (((b) * 2 + (h)) * HTB)
#define PG8_SB(b, h) ((4 + (b) * 2 + (h)) * HTB)
#define PG8_STAGE(bufoff, gbase, voff) do { _Pragma("unroll") for (int _i = 0; _i < 2; ++_i) \
        __builtin_amdgcn_global_load_lds((const unsigned*)((const char*)(gbase) + (voff)[_i]), (LAS unsigned*)(lds + (bufoff) + ldsw + _i * 8192), 16, 0, 0); } while (0)
#define PG8_LDA(dst, b, h) do { _Pragma("unroll") for (int m = 0; m < 4; ++m) _Pragma("unroll") for (int k = 0; k < 2; ++k) dst[m][k] = *(const LAS bf16x8*)(lds + PG8_SA(b, h) + aoff + m * 2048 + k * 1024); } while (0)
#define PG8_LDB(dst, b, h) do { _Pragma("unroll") for (int n = 0; n < 2; ++n) _Pragma("unroll") for (int k = 0; k < 2; ++k) dst[n][k] = *(const LAS bf16x8*)(lds + PG8_SB(b, h) + boff + n * 2048 + k * 1024); } while (0)
#define PG8_MMA(ai, bj, At, Bt) do { __builtin_amdgcn_s_setprio(1); _Pragma("unroll") for (int m = 0; m < 4; ++m) _Pragma("unroll") for (int n = 0; n < 2; ++n) _Pragma("unroll") for (int k = 0; k < 2; ++k) \
        acc[ai][bj][m][n] = __builtin_amdgcn_mfma_f32_16x16x32_bf16(Bt[n][k], At[m][k], acc[ai][bj][m][n], 0, 0, 0); __builtin_amdgcn_s_setprio(0); } while (0)
#define PG8_WAIT_V(n) asm volatile("s_waitcnt vmcnt(" #n ")" ::: "memory")
#define PG8_WAIT_L(n) asm volatile("s_waitcnt lgkmcnt(" #n ")" ::: "memory")
#define PG8_BAR __builtin_amdgcn_s_barrier()
#define PG8_SCHED __builtin_amdgcn_sched_barrier(0)
    Unit cur, nxt; int ui = 0;
    if (!S.next(0, cur)) return;
    f32x4 acc[2][2][4][2];
#pragma unroll
    for (int a = 0; a < 2; ++a)
#pragma unroll
        for (int b = 0; b < 2; ++b)
#pragma unroll
            for (int m = 0; m < 4; ++m)
#pragma unroll
                for (int n = 0; n < 2; ++n) acc[a][b][m][n] = (f32x4){0.f, 0.f, 0.f, 0.f};
    bf16x8 At[4][2], B0[2][2], B1[2][2];
    const char* cA = (const char*)g.A + (size_t)cur.pm * tsA; const char* cB = (const char*)g.Bt + (size_t)cur.pn * tsB;
    int nt = g.K / BK;
    PG8_STAGE(PG8_SB(0, 0), cB, voffB); PG8_STAGE(PG8_SB(0, 1), cB + hsB, voffB); PG8_STAGE(PG8_SA(0, 0), cA, voffA); PG8_STAGE(PG8_SA(0, 1), cA + hsA, voffA);
    if (wr == 1) PG8_BAR;
    PG8_WAIT_V(2); PG8_BAR;
    PG8_STAGE(PG8_SB(1, 0), cB + kstep, voffB); PG8_STAGE(PG8_SA(1, 0), cA + kstep, voffA); PG8_STAGE(PG8_SB(1, 1), cB + hsB + kstep, voffB);
    PG8_WAIT_V(6); PG8_BAR;
    for (;;) {
        bool has_next; const char* nA; const char* nB; int nnt = nt;
        if constexpr (DUAL) {
            const int which_n = (ui + 1) & 1;
            has_next = which_n ? true : S.next((ui + 1) >> 1, nxt); if (which_n) nxt = cur;
            const char* gA = (const char*)(which_n ? g1.A : g.A); const char* gB = (const char*)(which_n ? g1.Bt : g.Bt);
            nA = has_next ? gA + (size_t)nxt.pm * tsA : cA; nB = has_next ? gB + (size_t)nxt.pn * tsB : cB; nnt = (which_n ? g1.K : g.K) / BK;
        } else {
            has_next = S.next(ui + 1, nxt);
            nA = has_next ? (const char*)g.A + (size_t)nxt.pm * tsA : cA; nB = has_next ? (const char*)g.Bt + (size_t)nxt.pn * tsB : cB;
        }
        for (int t = 0; t < nt; t += 2) {
            const bool last = (t == nt - 2);
            const char* a1 = cA + (size_t)(t + 1) * kstep;
            const char* a2 = last ? nA : cA + (size_t)(t + 2) * kstep; const char* b2 = last ? nB : cB + (size_t)(t + 2) * kstep;
            const char* a3 = a2 + kstep; const char* b3 = b2 + kstep;
            PG8_LDB(B0, 0, 0); PG8_LDB(B1, 0, 1); PG8_SCHED; PG8_LDA(At, 0, 0); PG8_STAGE(PG8_SA(1, 1), a1 + hsA, voffA);
            PG8_WAIT_V(8); PG8_WAIT_L(0); PG8_BAR; PG8_MMA(0, 0, At, B0); PG8_MMA(0, 1, At, B1); PG8_BAR; PG8_SCHED;
            PG8_LDA(At, 0, 1); PG8_STAGE(PG8_SB(0, 0), b2, voffB); PG8_STAGE(PG8_SB(0, 1), b2 + hsB, voffB); PG8_STAGE(PG8_SA(0, 0), a2, voffA);
            PG8_WAIT_V(8); PG8_WAIT_L(0); PG8_BAR; PG8_MMA(1, 0, At, B0); PG8_MMA(1, 1, At, B1); PG8_BAR; PG8_SCHED;
            PG8_LDB(B0, 1, 0); PG8_LDB(B1, 1, 1); PG8_SCHED; PG8_LDA(At, 1, 0); PG8_STAGE(PG8_SA(0, 1), a2 + hsA, voffA);
            PG8_WAIT_V(8); PG8_WAIT_L(0); PG8_BAR; PG8_MMA(0, 0, At, B0); PG8_MMA(0, 1, At, B1); PG8_BAR; PG8_SCHED;
            PG8_LDA(At, 1, 1); PG8_STAGE(PG8_SB(1, 0), b3, voffB); PG8_STAGE(PG8_SB(1, 1), b3 + hsB, voffB); PG8_STAGE(PG8_SA(1, 0), a3, voffA);
            PG8_WAIT_V(8); PG8_WAIT_L(0); PG8_BAR; PG8_MMA(1, 0, At, B0); PG8_MMA(1, 1, At, B1); PG8_BAR; PG8_SCHED;
            if constexpr (Epi::HOOK_T > 0) { if (t + 2 == Epi::HOOK_T) E.mid(acc, cur, wr, wc, fr, fq); }
        }
        if (wr == 0) PG8_BAR;
        E(acc, cur, wr, wc, fr, fq, DUAL ? (ui & 1) : 0);
        if (!has_next) break;
#pragma unroll
        for (int a = 0; a < 2; ++a)
#pragma unroll
            for (int b = 0; b < 2; ++b)
#pragma unroll
                for (int m = 0; m < 4; ++m)
#pragma unroll
                    for (int n = 0; n < 2; ++n) acc[a][b][m][n] = (f32x4){0.f, 0.f, 0.f, 0.f};
        cur = nxt; cA = nA; cB = nB; nt = nnt; ++ui;
        if (wr == 1) PG8_BAR;
    }
    PG8_WAIT_V(0);
    PG8_BAR;
#undef PG8_SA
#undef PG8_SB
#undef PG8_STAGE
#undef PG8_LDA
#undef PG8_LDB
#undef PG8_MMA
#undef PG8_WAIT_V
#undef PG8_WAIT_L
#undef PG8_BAR
#undef PG8_SCHED
}
}

typedef f32x4 AccT[2][2][4][2];
#define ACC_E(acc, ai, bj, m, e) ((acc)[ai][bj][m][(e) >> 2][(e) & 3])
__device__ __forceinline__ u32x4 pack8(const float* v) { u32x4 w; w.x = cvt_pk_bf16(v[0], v[1]); w.y = cvt_pk_bf16(v[2], v[3]); w.z = cvt_pk_bf16(v[4], v[5]); w.w = cvt_pk_bf16(v[6], v[7]); return w; }

struct EpiIn {
    static constexpr int HOOK_T = 0;
    bf16_t *q, *k, *v, *a; unsigned short* gates;
    const float *qn, *kn, *bglu; const f32x2* rope;
    float *out_nk, *out_nv, *out_nc;
    __device__ __forceinline__ void operator()(const AccT& acc, const pg8::Unit& u, int wr, int wc, int fr, int fq, int which) const {
        asm volatile("" : "+v"(fr), "+v"(fq));
        const int pn = u.pn; const int row0 = u.pm * 256 + wr * 64 + fr;
        const bool lastb = (u.pm & 31) == 31; const int b = u.pm >> 5;
        if (pn < 5) {
            const bool isq = pn < 4; const float* nw = isq ? qn : kn; const float osc = isq ? QSCALE : 1.f;
            float wn[2][8];
#pragma unroll
            for (int bj = 0; bj < 2; ++bj) { const f32x4 w0 = *(const f32x4*)(nw + 32 * bj + 8 * fq), w1 = *(const f32x4*)(nw + 32 * bj + 8 * fq + 4);
                wn[bj][0] = w0[0]; wn[bj][1] = w0[1]; wn[bj][2] = w0[2]; wn[bj][3] = w0[3]; wn[bj][4] = w1[0]; wn[bj][5] = w1[1]; wn[bj][6] = w1[2]; wn[bj][7] = w1[3]; }
            f32x4 cs[2][4]; u32x4 pk1[2], pk2[2];
#pragma unroll
            for (int qt = 0; qt < 4; ++qt) {
                const int ai = qt >> 1, mb = (qt & 1) * 2;
#pragma unroll
                for (int mm = 0; mm < 2; ++mm) { const int pos = (row0 + ai * 128 + (mb + mm) * 16) & (SEQ - 1); const f32x4* rp = (const f32x4*)(rope + (size_t)pos * 32 + 8 * fq);
#pragma unroll
                    for (int e2 = 0; e2 < 4; ++e2) cs[mm][e2] = rp[e2]; }
                asm volatile("" ::: "memory");
                if (qt > 0) { const int pai = (qt - 1) >> 1, pmb = ((qt - 1) & 1) * 2;
#pragma unroll
                    for (int mm = 0; mm < 2; ++mm) { const int row = row0 + pai * 128 + (pmb + mm) * 16;
                        bf16_t* dst = isq ? q + (size_t)row * DM + (4 * pn + wc) * 64 + 8 * fq : k + (size_t)row * 256 + wc * 64 + 8 * fq;
                        *(u32x4*)dst = pk1[mm]; *(u32x4*)(dst + 32) = pk2[mm]; }
                    asm volatile("" ::: "memory");
                }
#pragma unroll
                for (int mm = 0; mm < 2; ++mm) { const int m = mb + mm;
                    const int row = row0 + ai * 128 + m * 16; const int pos = row & (SEQ - 1);
                    float ss = 0.f;
#pragma unroll
                    for (int bj = 0; bj < 2; ++bj)
#pragma unroll
                        for (int e = 0; e < 8; ++e) { const float x = ACC_E(acc, ai, bj, m, e); ss += x * x; }
                    ss += __shfl_xor(ss, 16); ss += __shfl_xor(ss, 32);
                    const float rs = rsqrtf(ss * (1.f / 64.f) + EPS);
                    float o1[8], o2[8];
#pragma unroll
                    for (int e2 = 0; e2 < 4; ++e2) { const f32x4 c4 = cs[mm][e2];
                        { const int e = 2 * e2; const float x1 = ACC_E(acc, ai, 0, m, e) * rs * wn[0][e], x2 = ACC_E(acc, ai, 1, m, e) * rs * wn[1][e];
                          o1[e] = (x1 * c4[0] - x2 * c4[1]) * osc; o2[e] = (x2 * c4[0] + x1 * c4[1]) * osc; }
                        { const int e = 2 * e2 + 1; const float x1 = ACC_E(acc, ai, 0, m, e) * rs * wn[0][e], x2 = ACC_E(acc, ai, 1, m, e) * rs * wn[1][e];
                          o1[e] = (x1 * c4[2] - x2 * c4[3]) * osc; o2[e] = (x2 * c4[2] + x1 * c4[3]) * osc; } }
                    pk1[mm] = pack8(o1); pk2[mm] = pack8(o2);
                    if (!isq && lastb && ai == 1) { float* f = out_nk + ((size_t)(b * 128 + (pos - (SEQ - 128))) * 256) + wc * 64 + 8 * fq;
                        *(f32x4*)f = (f32x4){o1[0], o1[1], o1[2], o1[3]}; *(f32x4*)(f + 4) = (f32x4){o1[4], o1[5], o1[6], o1[7]};
                        *(f32x4*)(f + 32) = (f32x4){o2[0], o2[1], o2[2], o2[3]}; *(f32x4*)(f + 36) = (f32x4){o2[4], o2[5], o2[6], o2[7]}; }
                }
            }
#pragma unroll
            for (int mm = 0; mm < 2; ++mm) { const int row = row0 + 128 + (2 + mm) * 16;
                bf16_t* dst = isq ? q + (size_t)row * DM + (4 * pn + wc) * 64 + 8 * fq : k + (size_t)row * 256 + wc * 64 + 8 * fq;
                *(u32x4*)dst = pk1[mm]; *(u32x4*)(dst + 32) = pk2[mm]; }
        } else if (pn == 5) {
#pragma unroll
            for (int ai = 0; ai < 2; ++ai)
#pragma unroll
                for (int m = 0; m < 4; ++m) {
                    const int row = row0 + ai * 128 + m * 16; const int pos = row & (SEQ - 1);
#pragma unroll
                    for (int bj = 0; bj < 2; ++bj) { const int col = 128 * bj + 32 * wc + 8 * fq;
                        float o[8];
#pragma unroll
                        for (int e = 0; e < 8; ++e) o[e] = ACC_E(acc, ai, bj, m, e);
                        *(u32x4*)(v + (size_t)row * 256 + col) = pack8(o);
                        if (lastb && ai == 1) { float* f = out_nv + (size_t)(b * 128 + (pos - (SEQ - 128))) * 256 + col;
                            *(f32x4*)f = acc[ai][bj][m][0]; *(f32x4*)(f + 4) = acc[ai][bj][m][1]; } }
                }
        } else if (pn < 14) {
            const int c0 = 128 * (pn - 6) + 32 * wc + 8 * fq;
            float bv[8], bg[8];
            { const f32x4 a0 = *(const f32x4*)(bglu + c0), a1 = *(const f32x4*)(bglu + c0 + 4), g0 = *(const f32x4*)(bglu + DM + c0), g1 = *(const f32x4*)(bglu + DM + c0 + 4);
#pragma unroll
              for (int e = 0; e < 4; ++e) { bv[e] = a0[e]; bv[e + 4] = a1[e]; bg[e] = g0[e]; bg[e + 4] = g1[e]; } }
#pragma unroll
            for (int ai = 0; ai < 2; ++ai)
#pragma unroll
                for (int m = 0; m < 4; ++m) {
                    const int row = row0 + ai * 128 + m * 16; const int pos = row & (SEQ - 1);
                    float o[8];
#pragma unroll
                    for (int e = 0; e < 8; ++e) o[e] = (ACC_E(acc, ai, 0, m, e) + bv[e]) * fsigmoid(ACC_E(acc, ai, 1, m, e) + bg[e]);
                    *(u32x4*)(a + (size_t)row * DM + c0) = pack8(o);
                    if (lastb && ai == 1 && pos >= SEQ - 30) { float* f = out_nc + (size_t)(b * 30 + (pos - (SEQ - 30))) * DM + c0;
                        *(f32x4*)f = (f32x4){o[0], o[1], o[2], o[3]}; *(f32x4*)(f + 4) = (f32x4){o[4], o[5], o[6], o[7]}; }
                }
        } else {
            const int c0 = 128 * (pn - 14) + 32 * wc + 8 * fq;
#pragma unroll
            for (int ai = 0; ai < 2; ++ai)
#pragma unroll
                for (int m = 0; m < 4; ++m) {
                    const int row = row0 + ai * 128 + m * 16;
                    unsigned g[8];
#pragma unroll
                    for (int e = 0; e < 8; ++e) { const unsigned qa = (unsigned)(fsigmoid(ACC_E(acc, ai, 0, m, e)) * 255.f + 0.5f); unsigned qc = (unsigned)(fsigmoid(ACC_E(acc, ai, 1, m, e)) * 255.f + 0.5f); qc = qc < 1u ? 1u : qc;
                        g[e] = qa | (qc << 8); }
                    u32x4 w; w.x = g[0] | (g[1] << 16); w.y = g[2] | (g[3] << 16); w.z = g[4] | (g[5] << 16); w.w = g[6] | (g[7] << 16);
                    *(u32x4*)(gates + (size_t)row * DM + c0) = w;
                }
        }
    }
};

struct EpiMix {
    static constexpr int HOOK_T = 16;
    const unsigned short* gates; const float* bco; bf16_t* mixed;
    __device__ __forceinline__ void mid(AccT& acc, const pg8::Unit& u, int wr, int wc, int fr, int fq) const {
        asm volatile("" : "+v"(fr), "+v"(fq));
        const int row0 = u.pm * 256 + wr * 64 + fr;
        f32x4 bb[2][2];
#pragma unroll
        for (int bj = 0; bj < 2; ++bj) { const int col = u.pn * 256 + 128 * bj + 32 * wc + 8 * fq; bb[bj][0] = *(const f32x4*)(bco + col); bb[bj][1] = *(const f32x4*)(bco + col + 4); }
        u32x4 r2[2][4][2];
#pragma unroll
        for (int ai = 0; ai < 2; ++ai)
#pragma unroll
            for (int m = 0; m < 4; ++m)
#pragma unroll
                for (int bj = 0; bj < 2; ++bj) r2[ai][m][bj] = *(const u32x4*)(gates + (size_t)(row0 + ai * 128 + m * 16) * DM + u.pn * 256 + 128 * bj + 32 * wc + 8 * fq);
        asm volatile("" ::: "memory");
#pragma unroll
        for (int ai = 0; ai < 2; ++ai) {
#pragma unroll
            for (int m = 0; m < 4; ++m)
#pragma unroll
                for (int bj = 0; bj < 2; ++bj) { const u32x4 q = r2[ai][m][bj]; const unsigned w[4] = {q.x, q.y, q.z, q.w};
#pragma unroll
                    for (int e2 = 0; e2 < 4; ++e2) {
                        const float a0 = (float)(w[e2] & 0xffu), c0 = (float)((w[e2] >> 8) & 0xffu), a1 = (float)((w[e2] >> 16) & 0xffu), c1 = (float)(w[e2] >> 24);
                        ACC_E(acc, ai, bj, m, 2 * e2) = ACC_E(acc, ai, bj, m, 2 * e2) * (a0 * __builtin_amdgcn_rcpf(c0)) + bb[bj][(2 * e2) >> 2][(2 * e2) & 3];
                        ACC_E(acc, ai, bj, m, 2 * e2 + 1) = ACC_E(acc, ai, bj, m, 2 * e2 + 1) * (a1 * __builtin_amdgcn_rcpf(c1)) + bb[bj][(2 * e2 + 1) >> 2][(2 * e2 + 1) & 3]; } }
            asm volatile("" ::: "memory");
        }
    }
    __device__ __forceinline__ void operator()(const AccT& acc, const pg8::Unit& u, int wr, int wc, int fr, int fq, int which) const {
        asm volatile("" : "+v"(fr), "+v"(fq));
        const int row0 = u.pm * 256 + wr * 64 + fr;
        u32x4 s2[2][4][2];
#pragma unroll
        for (int ai = 0; ai < 2; ++ai)
#pragma unroll
            for (int m = 0; m < 4; ++m)
#pragma unroll
                for (int bj = 0; bj < 2; ++bj) s2[ai][m][bj] = __builtin_nontemporal_load((const u32x4*)(gates + (size_t)(row0 + ai * 128 + m * 16) * DM + u.pn * 256 + 128 * bj + 32 * wc + 8 * fq));
        asm volatile("" ::: "memory");
#pragma unroll
        for (int ai = 0; ai < 2; ++ai) {
#pragma unroll
            for (int m = 0; m < 4; ++m)
#pragma unroll
                for (int bj = 0; bj < 2; ++bj) { const u32x4 q = s2[ai][m][bj]; const unsigned w[4] = {q.x, q.y, q.z, q.w}; float o[8];
#pragma unroll
                    for (int e2 = 0; e2 < 4; ++e2) {
                        const float c0 = (float)((w[e2] >> 8) & 0xffu) * (1.f / 255.f), c1 = (float)(w[e2] >> 24) * (1.f / 255.f);
                        o[2 * e2] = ACC_E(acc, ai, bj, m, 2 * e2) * c0; o[2 * e2 + 1] = ACC_E(acc, ai, bj, m, 2 * e2 + 1) * c1; }
                    *(u32x4*)(mixed + (size_t)(row0 + ai * 128 + m * 16) * DM + u.pn * 256 + 128 * bj + 32 * wc + 8 * fq) = pack8(o); }
            asm volatile("" ::: "memory");
        }
    }
};

template <bool XREC> struct EpiResB {
    static constexpr int HOOK_T = 0;
    bf16_t* hs; float* rss; const float* xinv; const float* ln1;
    __device__ __forceinline__ void operator()(const AccT& acc, const pg8::Unit& u, int wr, int wc, int fr, int fq, int which) const {
        asm volatile("" : "+v"(fr), "+v"(fq));
        const int row0 = u.pm * 256 + wr * 64 + fr;
        u32x4 hv[4][2], pk[4][2]; float rsc[4], sq[4];
#pragma unroll
        for (int ai = 0; ai < 2; ++ai) {
#pragma unroll
            for (int m = 0; m < 4; ++m) { const int row = row0 + ai * 128 + m * 16; rsc[m] = XREC ? xinv[row] : 1.f;
#pragma unroll
                for (int bj = 0; bj < 2; ++bj) hv[m][bj] = *(const u32x4*)(hs + (size_t)row * DM + u.pn * 256 + 128 * bj + 32 * wc + 8 * fq); }
            asm volatile("" ::: "memory");
            if (ai == 1) {
#pragma unroll
                for (int m = 0; m < 4; ++m) { const int row = row0 + m * 16;
#pragma unroll
                    for (int bj = 0; bj < 2; ++bj) *(u32x4*)(hs + (size_t)row * DM + u.pn * 256 + 128 * bj + 32 * wc + 8 * fq) = pk[m][bj];
                    if (fq == 0) atomicAdd(rss + row, sq[m]); }
                asm volatile("" ::: "memory");
            }
#pragma unroll
            for (int m = 0; m < 4; ++m) { float ssq = 0.f;
#pragma unroll
                for (int bj = 0; bj < 2; ++bj) { const u32x4 hb = hv[m][bj];
                    float h[8] = {bf_lo(hb.x), bf_hi(hb.x), bf_lo(hb.y), bf_hi(hb.y), bf_lo(hb.z), bf_hi(hb.z), bf_lo(hb.w), bf_hi(hb.w)};
#pragma unroll
                    for (int e = 0; e < 8; ++e) { const float b = XREC ? h[e] * rsc[m] : h[e]; h[e] = b + ACC_E(acc, ai, bj, m, e); ssq += h[e] * h[e]; }
                    pk[m][bj] = pack8(h); }
                ssq += __shfl_xor(ssq, 16); ssq += __shfl_xor(ssq, 32); sq[m] = ssq; }
        }
#pragma unroll
        for (int m = 0; m < 4; ++m) { const int row = row0 + 128 + m * 16;
#pragma unroll
            for (int bj = 0; bj < 2; ++bj) *(u32x4*)(hs + (size_t)row * DM + u.pn * 256 + 128 * bj + 32 * wc + 8 * fq) = pk[m][bj];
            if (fq == 0) atomicAdd(rss + row, sq[m]); }
    }
};
__device__ __forceinline__ float row_rs1(const float* rss, int row) { return rsqrtf(rss[row] * (1.f / DM) + EPS); }
struct EpiFF1 {
    static constexpr int HOOK_T = 0;
    const float* rss; bf16_t* f;
    __device__ __forceinline__ void operator()(const AccT& acc, const pg8::Unit& u, int wr, int wc, int fr, int fq, int which) const {
        asm volatile("" : "+v"(fr), "+v"(fq));
        const int row0 = u.pm * 256 + wr * 64 + fr;
        float ss[2][4];
#pragma unroll
        for (int ai = 0; ai < 2; ++ai)
#pragma unroll
            for (int m = 0; m < 4; ++m) ss[ai][m] = rss[row0 + ai * 128 + m * 16];
        asm volatile("" ::: "memory");
#pragma unroll
        for (int ai = 0; ai < 2; ++ai)
#pragma unroll
            for (int m = 0; m < 4; ++m) {
                const int row = row0 + ai * 128 + m * 16; const float rs = rsqrtf(ss[ai][m] * (1.f / DM) + EPS);
#pragma unroll
                for (int bj = 0; bj < 2; ++bj) { float o[8];
#pragma unroll
                    for (int e = 0; e < 8; ++e) { const float t = fmaxf(ACC_E(acc, ai, bj, m, e) * rs, 0.f); o[e] = t * t; }
                    __builtin_nontemporal_store(pack8(o), (u32x4*)(f + (size_t)row * DFF + u.pn * 256 + 128 * bj + 32 * wc + 8 * fq)); }
            }
    }
};
struct EpiGate2 {
    static constexpr int HOOK_T = 0;
    const float* rss; const bf16_t* h2; float* y;
    __device__ __forceinline__ EpiGate2(const float* r_, const bf16_t* h_, float* y_) : rss(r_), h2(h_), y(y_) {}
    mutable u32x2 gst[2][4][2];
    __device__ __forceinline__ void operator()(const AccT& acc, const pg8::Unit& u, int wr, int wc, int fr, int fq, int which) const {
        asm volatile("" : "+v"(fr), "+v"(fq));
        const int row0 = u.pm * 256 + wr * 64 + fr;
        if (which == 0) {
            float ss[2][4];
#pragma unroll
            for (int ai = 0; ai < 2; ++ai)
#pragma unroll
                for (int m = 0; m < 4; ++m) ss[ai][m] = rss[row0 + ai * 128 + m * 16];
            asm volatile("" ::: "memory");
#pragma unroll
            for (int ai = 0; ai < 2; ++ai)
#pragma unroll
                for (int m = 0; m < 4; ++m) {
                    const int row = row0 + ai * 128 + m * 16; const float rs = rsqrtf(ss[ai][m] * (1.f / DM) + EPS);
#pragma unroll
                    for (int bj = 0; bj < 2; ++bj) { const size_t off = (size_t)row * DM + u.pn * 256 + 128 * bj + 32 * wc + 8 * fq; float o[8];
#pragma unroll
                        for (int e = 0; e < 8; ++e) o[e] = fsigmoid(ACC_E(acc, ai, bj, m, e) * rs) * 255.f + 0.5f;
                        u32x2 w; w.x = (unsigned)o[0] | ((unsigned)o[1] << 8) | ((unsigned)o[2] << 16) | ((unsigned)o[3] << 24); w.y = (unsigned)o[4] | ((unsigned)o[5] << 8) | ((unsigned)o[6] << 16) | ((unsigned)o[7] << 24);
                        (void)off; gst[ai][m][bj] = w; }
                }
        } else {
            u32x4 hb[2][2];
#define EG2_LOAD(s_, buf_) do { _Pragma("unroll") for (int bj = 0; bj < 2; ++bj) { \
                const size_t off_ = (size_t)(row0 + ((s_) >> 2) * 128 + ((s_) & 3) * 16) * DM + u.pn * 256 + 128 * bj + 32 * wc + 8 * fq; hb[buf_][bj] = *(const u32x4*)(h2 + off_); } } while (0)
            EG2_LOAD(0, 0);
#pragma unroll
            for (int s = 0; s < 8; ++s) {
                const int ai = s >> 2, m = s & 3;
                if (s < 7) EG2_LOAD(s + 1, (s + 1) & 1);
                asm volatile("" ::: "memory");
#pragma unroll
                for (int bj = 0; bj < 2; ++bj) { const u32x4 hq = hb[s & 1][bj]; const u32x2 gq = gst[ai][m][bj]; const size_t off = (size_t)(row0 + ai * 128 + m * 16) * DM + u.pn * 256 + 128 * bj + 32 * wc + 8 * fq;
                    const float h[8] = {bf_lo(hq.x), bf_hi(hq.x), bf_lo(hq.y), bf_hi(hq.y), bf_lo(hq.z), bf_hi(hq.z), bf_lo(hq.w), bf_hi(hq.w)};
                    const float gt[8] = {(float)(gq.x & 0xffu) * (1.f / 255.f), (float)((gq.x >> 8) & 0xffu) * (1.f / 255.f), (float)((gq.x >> 16) & 0xffu) * (1.f / 255.f), (float)(gq.x >> 24) * (1.f / 255.f),
                                         (float)(gq.y & 0xffu) * (1.f / 255.f), (float)((gq.y >> 8) & 0xffu) * (1.f / 255.f), (float)((gq.y >> 16) & 0xffu) * (1.f / 255.f), (float)(gq.y >> 24) * (1.f / 255.f)};
                    f32x4 o0, o1;
#pragma unroll
                    for (int e = 0; e < 4; ++e) { o0[e] = h[e] + gt[e] * ACC_E(acc, ai, bj, m, e); o1[e] = h[e + 4] + gt[e + 4] * ACC_E(acc, ai, bj, m, e + 4); }
                    *(f32x4*)(y + off) = o0; *(f32x4*)(y + off + 4) = o1; }
                asm volatile("" ::: "memory");
            }
#undef EG2_LOAD
        }
    }
};

struct MiniPart { const bf16_t* A; int lda; const bf16_t* Bt; int ldb; int K; };
__device__ __forceinline__ int crow(int r, int hi) { return (r & 3) + 8 * (r >> 2) + 4 * hi; }
template <int NP, class Epi>
__device__ __forceinline__ void mini_gemm(LAS unsigned char* lds, const MiniPart p0, const MiniPart p1, int N, const Epi& E, int blk, int G, int jlo = 0, int jhi = 1 << 20) {
    int tid_ = threadIdx.x; asm volatile("" : "+v"(tid_));
    const int tid = tid_, wave = __builtin_amdgcn_readfirstlane(tid >> 6), lane = tid & 63, i32 = lane & 31, hi = lane >> 5;
    LAS float* red = (LAS float*)lds;
    const int nitems = 4 * (N >> 5);
    for (int j = jlo, item = blk + jlo * G; j < jhi && item < nitems; ++j, item += G) {
        const int rt = item & 3, ct = item >> 2;
        f32x16 acc[NP];
#pragma unroll
        for (int p = 0; p < NP; ++p) {
            const MiniPart& P = p == 0 ? p0 : p1;
            acc[p] = (f32x16){0.f, 0.f, 0.f, 0.f, 0.f, 0.f, 0.f, 0.f, 0.f, 0.f, 0.f, 0.f, 0.f, 0.f, 0.f, 0.f};
            const int kw = P.K >> 3; const int k0 = wave * kw;
            const bf16_t* ap = P.A + (size_t)(32 * rt + i32) * P.lda + k0 + 8 * hi; const bf16_t* bp = P.Bt + (size_t)(32 * ct + i32) * P.ldb + k0 + 8 * hi;
            if (kw >= 128) {
                for (int kk = 0; kk < kw; kk += 128) {
                    bf16x8 af[8], bfr[8];
#pragma unroll
                    for (int i = 0; i < 8; ++i) { af[i] = *(const bf16x8*)(ap + kk + 16 * i); bfr[i] = *(const bf16x8*)(bp + kk + 16 * i); }
                    asm volatile("" ::: "memory");
#pragma unroll
                    for (int i = 0; i < 8; ++i) acc[p] = __builtin_amdgcn_mfma_f32_32x32x16_bf16(af[i], bfr[i], acc[p], 0, 0, 0);
                }
            } else {
                for (int kk = 0; kk < kw; kk += 32) {
                    const bf16x8 a0 = *(const bf16x8*)(ap + kk), b0 = *(const bf16x8*)(bp + kk), a1 = *(const bf16x8*)(ap + kk + 16), b1 = *(const bf16x8*)(bp + kk + 16);
                    acc[p] = __builtin_amdgcn_mfma_f32_32x32x16_bf16(a0, b0, acc[p], 0, 0, 0); acc[p] = __builtin_amdgcn_mfma_f32_32x32x16_bf16(a1, b1, acc[p], 0, 0, 0);
                }
            }
        }
#pragma unroll
        for (int p = 0; p < NP; ++p)
#pragma unroll
            for (int r = 0; r < 16; ++r) red[((p * 8 + wave) * 32 + crow(r, hi)) * 33 + i32] = acc[p][r];
        __syncthreads();
#pragma unroll
        for (int half = 0; half < 2; ++half) {
            const int i = (tid >> 5) + 16 * half, j = tid & 31; float v[NP];
#pragma unroll
            for (int p = 0; p < NP; ++p) { float s = 0.f;
#pragma unroll
                for (int w = 0; w < 8; ++w) s += red[((p * 8 + w) * 32 + i) * 33 + j];
                v[p] = s; }
            E(32 * rt + i, 32 * ct + j, v);
        }
        __syncthreads();
    }
}
__device__ __forceinline__ float half_sum32(float v) {
#pragma unroll
    for (int o = 1; o < 32; o <<= 1) v += __shfl_xor(v, o);
    return v;
}
__device__ __forceinline__ float row_rs32(const float* rss, int row) { float s = 0.f;
#pragma unroll
    for (int i = 0; i < 8; ++i) { const f32x4 a = *(const f32x4*)(rss + (size_t)row * 32 + 4 * i); s += (a[0] + a[1]) + (a[2] + a[3]); }
    return rsqrtf(s * (1.f / DM) + EPS); }
struct MEpiZ { float* zs; __device__ __forceinline__ void operator()(int row, int col, const float* v) const { zs[(size_t)row * DIN + perm_in(col)] = v[0]; } };
struct MEpiMix { const float* zs; const float* bco; bf16_t* mixed;
    __device__ __forceinline__ void operator()(int row, int col, const float* v) const {
        const float sa = fsigmoid(zs[(size_t)row * DIN + 3584 + col]), sc = fsigmoid(zs[(size_t)row * DIN + 4608 + col]);
        const float r = sa * v[0] + sc * (v[1] + bco[col]);
        mixed[(size_t)row * DM + col] = (bf16_t)(cvt_pk_bf16(r, 0.f) & 0xffffu); } };
struct MEpiRes { const float* base; float* out; bf16_t* ob; float* rss;
    __device__ __forceinline__ void operator()(int row, int col, const float* v) const {
        const float h = base[(size_t)row * DM + col] + v[0]; out[(size_t)row * DM + col] = h; ob[(size_t)row * DM + col] = (bf16_t)(cvt_pk_bf16(h, 0.f) & 0xffffu);
        const float s = half_sum32(h * h); if ((col & 31) == 0) rss[(size_t)row * 32 + (col >> 5)] = s; } };
struct MEpiFF1 { const float* rss; bf16_t* f;
    __device__ __forceinline__ void operator()(int row, int col, const float* v) const {
        const float t = fmaxf(v[0] * row_rs32(rss, row), 0.f); f[(size_t)row * DFF + col] = (bf16_t)(cvt_pk_bf16(t * t, 0.f) & 0xffffu); } };
struct MEpiGate { const float* rss; float* y;
    __device__ __forceinline__ void operator()(int row, int col, const float* v) const {
        const float g = fsigmoid(v[1] * row_rs32(rss, row)); y[(size_t)row * DM + col] += g * v[0]; } };

constexpr size_t MiB = 1u << 20;
constexpr size_t WS_CTL = 0;
constexpr size_t WS_WIN = 2 * MiB, WS_WOC = 14 * MiB, WS_WOUT = 18 * MiB, WS_WFF1 = 20 * MiB, WS_WFF2 = 28 * MiB, WS_WPG = 36 * MiB, WS_WPLE = 118 * MiB;
constexpr size_t WS_ROPE = 39 * MiB, WS_XINV = 41 * MiB + 512 * 1024, WS_RSS1 = 65536, WS_RSS2 = 65536 + 131072;
constexpr size_t WS_ZS = 46 * MiB, WS_AOYC_S = 49 * MiB, WS_MIX_S = WS_AOYC_S + 512 * 1024, WS_HB_S = WS_MIX_S + 256 * 1024, WS_F_S = 50 * MiB, WS_H2B_S = 51 * MiB,
                 WS_PP_S = WS_H2B_S + 256 * 1024, WS_RSS1_S = WS_PP_S + 512 * 1024, WS_RSS2_S = WS_RSS1_S + 16 * 1024;
constexpr size_t WS_U = 52 * MiB;
constexpr size_t WS_PB = 422 * MiB;
constexpr size_t WS_BIG = 134 * MiB;
constexpr size_t WS_Q = WS_BIG, WS_K = WS_BIG + 64 * MiB, WS_V = WS_BIG + 80 * MiB, WS_A = WS_BIG + 96 * MiB, WS_RR = WS_BIG + 160 * MiB, WS_SGC = WS_BIG + 224 * MiB;
constexpr size_t WS_MIXED = WS_Q;
constexpr size_t WS_F = WS_BIG;
constexpr size_t WS_END = 487 * MiB;
static_assert(WS_RSS2_S + 16 * 1024 <= WS_U && WS_U + (size_t)MT * DM * 2 <= WS_WPLE && WS_WPLE + 2 * MiB <= WS_BIG && WS_PB + (size_t)MT * DM * 2 <= WS_END, "ws map");
constexpr size_t OUT_Y = 0, OUT_YS = (size_t)MP * DM, OUT_NK = OUT_YS + (size_t)NS * DM, OUT_NV = OUT_NK + 4 * 128 * 256, OUT_NC = OUT_NV + 4 * 128 * 256,
                 OUT_NKS = OUT_NC + 4 * 30 * DM, OUT_NVS = OUT_NKS + (size_t)NS * 128 * 256, OUT_NCS = OUT_NVS + (size_t)NS * 128 * 256, OUT_END = OUT_NCS + (size_t)NS * 30 * DM;

constexpr int RING_BYTES = 131072, LDS_BYTES = 147456;

struct Args { const float* in[27]; float* out; unsigned char* ws; int ph_lo, ph_hi; };
typedef const __attribute__((address_space(4))) Args* ArgsP;
__device__ __forceinline__ ArgsP kargs() { ArgsP p = (ArgsP)__builtin_amdgcn_kernarg_segment_ptr(); asm volatile("" : "+s"(p)); return p; }
enum { I_XP = 0, I_XS, I_CK, I_CV, I_SC, I_PP, I_PS, I_LN1, I_WIN, I_BGLU, I_QN, I_KN, I_SINKS, I_WOA, I_CDW, I_CDWB, I_CLNG, I_CLNB, I_WCO, I_BCO, I_WOUT, I_LN2, I_WFF1, I_WFF2, I_LNPLE, I_WPG, I_WPLE };

__device__ __forceinline__ unsigned f2bf(float f) { unsigned u = __float_as_uint(f); return (u + 0x7fffu + ((u >> 16) & 1u)) >> 16; }
__device__ __forceinline__ unsigned pk2(float lo, float hi) { return f2bf(lo) | (f2bf(hi) << 16); }
template <bool NTS = false> __device__ __forceinline__ void p0_transpose_item(const float* W, int N, int src_col0, int k0, const float* ksc, bf16_t* WT, int ldk, int dst_row0, int dst_k0, LAS float* scr, int lane) {
    float tv[32];
#pragma unroll
    for (int i = 0; i < 32; ++i) { const int kk = 2 * i + (lane >> 5); tv[i] = __builtin_nontemporal_load(&W[(size_t)(k0 + kk) * N + src_col0 + (lane & 31)]); }
    if (ksc) {
#pragma unroll
        for (int i = 0; i < 32; ++i) tv[i] *= ksc[k0 + 2 * i + (lane >> 5)];
    }
#pragma unroll
    for (int i = 0; i < 32; ++i) scr[(2 * i + (lane >> 5)) * 33 + (lane & 31)] = tv[i];
    asm volatile("s_waitcnt lgkmcnt(0)" ::: "memory");
    const int c = lane & 7;
#pragma unroll
    for (int j = 0; j < 4; ++j) { const int n = (lane >> 3) + 8 * j; const LAS float* s = scr + (8 * c) * 33 + n;
        u32x4 o; o.x = pk2(s[0 * 33], s[1 * 33]); o.y = pk2(s[2 * 33], s[3 * 33]); o.z = pk2(s[4 * 33], s[5 * 33]); o.w = pk2(s[6 * 33], s[7 * 33]);
        if constexpr (NTS) __builtin_nontemporal_store(o, (u32x4*)(WT + (size_t)(dst_row0 + n) * ldk + dst_k0 + k0 + 8 * c)); else *(u32x4*)(WT + (size_t)(dst_row0 + n) * ldk + dst_k0 + k0 + 8 * c) = o; }
    asm volatile("s_waitcnt lgkmcnt(0)" ::: "memory");
}

template <int PART> __device__ __forceinline__ void phase0(LAS unsigned char* lds, int blk, int G) {
    const ArgsP ap = kargs();
    int tid_ = threadIdx.x; asm volatile("" : "+v"(tid_));
    const int tid = tid_, wave = __builtin_amdgcn_readfirstlane(tid >> 6), lane = tid & 63;
    unsigned char* ws = ap->ws;
    LAS float* scr = (LAS float*)(lds + wave * 16384);
    const int gw = blk * 8 + wave, NGW = G * 8;
    bf16_t* Win_t = (bf16_t*)(ws + WS_WIN); bf16_t* Woc_t = (bf16_t*)(ws + WS_WOC); bf16_t* Wout_t = (bf16_t*)(ws + WS_WOUT); bf16_t* Wff1_t = (bf16_t*)(ws + WS_WFF1);
    bf16_t* Wff2_t = (bf16_t*)(ws + WS_WFF2); bf16_t* Wpg_t = (bf16_t*)(ws + WS_WPG); bf16_t* Wple_t = (bf16_t*)(ws + WS_WPLE);
    constexpr int NITEMS = 2816 + 512 * 3 + 2048 * 2 + 512 + 128;
    constexpr int IT_LO = PART == 0 ? 0 : 2816, IT_HI = PART == 0 ? 2816 : NITEMS;
    for (int it0 = IT_LO + gw; it0 < IT_HI; it0 += NGW) {
        int it = it0;
        if (it < 2816) { const int kb = it / 176, nb = it % 176; p0_transpose_item(ap->in[I_WIN], DIN, perm_in(32 * nb), 64 * kb, ap->in[I_LN1], Win_t, DM, 32 * nb, 0, scr, lane); continue; } it -= 2816;
        if (it < 512) { const int kb = it >> 5, nb = it & 31; p0_transpose_item(ap->in[I_WOA], DM, 32 * nb, 64 * kb, nullptr, Woc_t, 2048, 32 * nb, 0, scr, lane); continue; } it -= 512;
        if (it < 512) { const int kb = it >> 5, nb = it & 31; p0_transpose_item(ap->in[I_WCO], DM, 32 * nb, 64 * kb, nullptr, Woc_t, 2048, 32 * nb, 1024, scr, lane); continue; } it -= 512;
        if (it < 512) { const int kb = it >> 5, nb = it & 31; p0_transpose_item(ap->in[I_WOUT], DM, 32 * nb, 64 * kb, nullptr, Wout_t, DM, 32 * nb, 0, scr, lane); continue; } it -= 512;
        if (it < 2048) { const int kb = it >> 7, nb = it & 127; p0_transpose_item<true>(ap->in[I_WFF1], DFF, 32 * nb, 64 * kb, ap->in[I_LN2], Wff1_t, DM, 32 * nb, 0, scr, lane); continue; } it -= 2048;
        if (it < 2048) { const int kb = it >> 5, nb = it & 31; p0_transpose_item<true>(ap->in[I_WFF2], DM, 32 * nb, 64 * kb, nullptr, Wff2_t, DFF, 32 * nb, 0, scr, lane); continue; } it -= 2048;
        if (it < 512) { const int kb = it >> 5, nb = it & 31; p0_transpose_item<true>(ap->in[I_WPG], DM, 32 * nb, 64 * kb, ap->in[I_LNPLE], Wpg_t, DM, 32 * nb, 0, scr, lane); continue; } it -= 512;
        { const int kb = it >> 5, nb = it & 31; p0_transpose_item<true>(ap->in[I_WPLE], DM, 32 * nb, 64 * kb, nullptr, Wple_t, DM, 32 * nb, 0, scr, lane); }
    }
    bf16_t* U = (bf16_t*)(ws + WS_U);
    if constexpr (PART == 0)
    for (int m0 = gw * 4; m0 < MT; m0 += NGW * 4) {
        f32x4 v[4][4];
#pragma unroll
        for (int r = 0; r < 4; ++r) { const int m = m0 + r; const f32x4* xr = (const f32x4*)(m < MP ? ap->in[I_XP] + (size_t)m * DM : ap->in[I_XS] + (size_t)(m - MP) * DM);
#pragma unroll
            for (int j = 0; j < 4; ++j) v[r][j] = __builtin_nontemporal_load(&xr[lane + 64 * j]); }
#pragma unroll
        for (int r = 0; r < 4; ++r) { const int m = m0 + r; float ss = 0.f;
#pragma unroll
            for (int j = 0; j < 4; ++j) ss += (v[r][j][0] * v[r][j][0] + v[r][j][1] * v[r][j][1]) + (v[r][j][2] * v[r][j][2] + v[r][j][3] * v[r][j][3]);
            const float ms = wave_sum(ss) * (1.f / DM) + EPS; const float rs = rsqrtf(ms);
            if (lane == 0) ((float*)(ws + WS_XINV))[m] = sqrtf(ms);
            u32x2* o = (u32x2*)(U + (size_t)m * DM);
#pragma unroll
            for (int j = 0; j < 4; ++j) { u32x2 w; w.x = pk2(v[r][j][0] * rs, v[r][j][1] * rs); w.y = pk2(v[r][j][2] * rs, v[r][j][3] * rs); o[lane + 64 * j] = w; } }
    }
    bf16_t* PB = (bf16_t*)(ws + WS_PB);
    if constexpr (PART == 1)
    for (int m0 = gw * 8; m0 < MT; m0 += NGW * 8) {
        f32x4 v[8];
#pragma unroll
        for (int r = 0; r < 8; ++r) { const int m = m0 + r; const f32x4* pr = (const f32x4*)(m < MP ? ap->in[I_PP] + (size_t)m * DPLE : ap->in[I_PS] + (size_t)(m - MP) * DPLE); v[r] = __builtin_nontemporal_load(&pr[lane]); }
#pragma unroll
        for (int r = 0; r < 8; ++r) { u32x2 w; w.x = pk2(v[r][0], v[r][1]); w.y = pk2(v[r][2], v[r][3]); __builtin_nontemporal_store(w, (u32x2*)(PB + (size_t)(m0 + r) * DM) + lane); }
    }
    f32x2* rope = (f32x2*)(ws + WS_ROPE);
    if constexpr (PART == 0)
    for (int idx = blk * 512 + tid; idx < 8193 * 32; idx += G * 512) {
        const int pr = idx >> 5, f = idx & 31; const int pos = pr < SEQ ? pr : 16384;
        double invd = 1.0; for (int i = 0; i < f; ++i) invd *= 0.74989420933245582730;
        const float invf = (float)invd; const float ang = (float)pos * invf;
        const double x = (double)ang; const double n = rint(x * 0.63661977236758134308);
        double r = fma(-n, 1.57079632679489655800, x); r = fma(-n, 6.12323399573676603587e-17, r);
        const double r2 = r * r;
        const double sp = r * (1.0 + r2 * (-1.0 / 6 + r2 * (1.0 / 120 + r2 * (-1.0 / 5040 + r2 * (1.0 / 362880 + r2 * (-1.0 / 39916800 + r2 * (1.0 / 6227020800.0)))))));
        const double cp = 1.0 + r2 * (-0.5 + r2 * (1.0 / 24 + r2 * (-1.0 / 720 + r2 * (1.0 / 40320 + r2 * (-1.0 / 3628800 + r2 * (1.0 / 479001600 + r2 * (-1.0 / 87178291200.0)))))));
        const int q = ((int)n) & 3;
        const double c = (q == 0) ? cp : (q == 1) ? -sp : (q == 2) ? -cp : sp;
        const double s = (q == 0) ? sp : (q == 1) ? cp : (q == 2) ? -sp : -cp;
        rope[idx] = (f32x2){(float)c, (float)s};
    }
}

struct P2Ctx { const bf16_t *q, *k, *v, *a; bf16_t* aoyc; const float* sinks; };

typedef short v4i16_t __attribute__((ext_vector_type(4)));
struct AttnPre { u32x4 k[3], v[3]; bf16x8 q[4]; };
__device__ __forceinline__ void attn_load(const P2Ctx& c, int unit, AttnPre& P, int tid, int wave, int lane) {
    const int kvh = unit & 3, qblk = (unit >> 2) & 127, b = unit >> 9; const int t0 = qblk * 64;
#pragma unroll
    for (int it = 0; it < 3; ++it) {
        const int ci = tid + it * 512; const int key = ci >> 3, ch = ci & 7; const int t = t0 - 128 + key;
        P.k[it] = (u32x4){0u, 0u, 0u, 0u}; P.v[it] = (u32x4){0u, 0u, 0u, 0u};
        if (t >= 0) { const size_t ro = (size_t)(b * SEQ + t) * 256 + kvh * 64 + ch * 8; P.k[it] = __builtin_nontemporal_load((const u32x4*)(c.k + ro)); P.v[it] = __builtin_nontemporal_load((const u32x4*)(c.v + ro)); }
    }
    const int g = wave & 3, s = wave >> 2, head = kvh * 4 + g, q = lane & 31, hi = lane >> 5;
    const size_t qrow = (size_t)b * SEQ + t0 + 32 * s + q;
#pragma unroll
    for (int ks = 0; ks < 4; ++ks) P.q[ks] = *(const bf16x8*)(c.q + qrow * DM + head * 64 + ks * 16 + hi * 8);
}
__device__ __forceinline__ void attn_stage(const AttnPre& P, LAS unsigned char* buf, int tid) {
    LAS unsigned char* Ks = buf; LAS unsigned char* Vt = buf + 27648;
#pragma unroll
    for (int it = 0; it < 3; ++it) {
        const int ci = tid + it * 512; const int key = ci >> 3, ch = ci & 7;
        *(LAS u32x4*)(Ks + key * 144 + ch * 16) = P.k[it];
        *(LAS u32x4*)(Vt + key * 144 + ch * 16) = P.v[it];
    }
}
__device__ __forceinline__ void attn_compute(const P2Ctx& c, int unit, const bf16x8 (&qf)[4], const LAS unsigned char* buf, int wave, int lane) {
    const int kvh = unit & 3, qblk = (unit >> 2) & 127, b = unit >> 9; const int t0 = qblk * 64;
    const LAS unsigned char* Ks = buf; const LAS unsigned char* Vt = buf + 27648;
    const int g = wave & 3, s = wave >> 2, head = kvh * 4 + g, q = lane & 31, hi = lane >> 5;
    const size_t qrow = (size_t)b * SEQ + t0 + 32 * s + q;
    f32x16 sc[5];
#pragma unroll
    for (int kt = 0; kt < 5; ++kt) {
        sc[kt] = (f32x16){0.f, 0.f, 0.f, 0.f, 0.f, 0.f, 0.f, 0.f, 0.f, 0.f, 0.f, 0.f, 0.f, 0.f, 0.f, 0.f};
#pragma unroll
        for (int ks = 0; ks < 4; ++ks) { const bf16x8 kf = *(const LAS bf16x8*)(Ks + (32 * s + 32 * kt + q) * 144 + ks * 32 + hi * 16); sc[kt] = __builtin_amdgcn_mfma_f32_32x32x16_bf16(kf, qf[ks], sc[kt], 0, 0, 0); }
    }
#pragma unroll
    for (int r = 0; r < 16; ++r) { const int i = crow(r, hi); if (i <= q) sc[0][r] = NEGBIG; if (i > q) sc[4][r] = NEGBIG; }
    if (t0 < 128) {
#pragma unroll
        for (int kt = 0; kt < 5; ++kt)
#pragma unroll
            for (int r = 0; r < 16; ++r) { const int tk = t0 - 128 + 32 * s + 32 * kt + crow(r, hi); if (tk < 0) sc[kt][r] = NEGBIG; }
    }
    const float sink2 = c.sinks[head] * LOG2E;
    float mx = sink2;
#pragma unroll
    for (int kt = 0; kt < 5; ++kt)
#pragma unroll
        for (int r = 0; r < 16; ++r) mx = fmaxf(mx, sc[kt][r]);
    mx = fmaxf(mx, __shfl_xor(mx, 32));
    float l = 0.f;
#pragma unroll
    for (int kt = 0; kt < 5; ++kt)
#pragma unroll
        for (int r = 0; r < 16; ++r) { const float p = __builtin_amdgcn_exp2f(sc[kt][r] - mx); sc[kt][r] = p; l += p; }
    l += __shfl_xor(l, 32); l += __builtin_amdgcn_exp2f(sink2 - mx);
    f32x16 o[2];
    o[0] = (f32x16){0.f, 0.f, 0.f, 0.f, 0.f, 0.f, 0.f, 0.f, 0.f, 0.f, 0.f, 0.f, 0.f, 0.f, 0.f, 0.f}; o[1] = o[0];
#pragma unroll
    for (int kt = 0; kt < 5; ++kt)
#pragma unroll
        for (int ks2 = 0; ks2 < 2; ++ks2) {
            u32x4 pw; pw.x = cvt_pk_bf16(sc[kt][8 * ks2 + 0], sc[kt][8 * ks2 + 1]); pw.y = cvt_pk_bf16(sc[kt][8 * ks2 + 2], sc[kt][8 * ks2 + 3]);
            pw.z = cvt_pk_bf16(sc[kt][8 * ks2 + 4], sc[kt][8 * ks2 + 5]); pw.w = cvt_pk_bf16(sc[kt][8 * ks2 + 6], sc[kt][8 * ks2 + 7]);
            const bf16x8 pb = __builtin_bit_cast(bf16x8, pw);
            const int kk0 = 32 * s + 32 * kt + 16 * ks2 + 4 * hi;
#pragma unroll
            for (int dt = 0; dt < 2; ++dt) {
                const LAS unsigned char* vp = Vt + (kk0 + ((lane & 15) >> 2)) * 144 + (32 * dt + 16 * ((lane >> 4) & 1) + 4 * (lane & 3)) * 2;
                const v4i16_t lo = __builtin_amdgcn_ds_read_tr16_b64_v4i16((LAS v4i16_t*)vp), h2 = __builtin_amdgcn_ds_read_tr16_b64_v4i16((LAS v4i16_t*)(vp + 8 * 144));
                const bf16x8 vw = {lo[0], lo[1], lo[2], lo[3], h2[0], h2[1], h2[2], h2[3]};
                o[dt] = __builtin_amdgcn_mfma_f32_32x32x16_bf16(vw, pb, o[dt], 0, 0, 0);
            }
        }
    const float inv = 1.f / l;
    bf16_t* op = c.aoyc + qrow * 2048 + head * 64;
#pragma unroll
    for (int dt = 0; dt < 2; ++dt)
#pragma unroll
        for (int j = 0; j < 4; ++j) { u32x2 w; w.x = cvt_pk_bf16(o[dt][4 * j] * inv, o[dt][4 * j + 1] * inv); w.y = cvt_pk_bf16(o[dt][4 * j + 2] * inv, o[dt][4 * j + 3] * inv);
            *(u32x2*)(op + 32 * dt + 8 * j + 4 * hi) = w; }
}

__device__ __forceinline__ void p2_conv(LAS unsigned char* lds, int blk, int G) {
    const ArgsP ap = kargs();
    int tid_ = threadIdx.x; asm volatile("" : "+v"(tid_));
    const int tid = tid_, wave = __builtin_amdgcn_readfirstlane(tid >> 6), lane = tid & 63;
    unsigned char* ws = ap->ws;
    P2Ctx c; c.q = (const bf16_t*)(ws + WS_Q); c.k = (const bf16_t*)(ws + WS_K); c.v = (const bf16_t*)(ws + WS_V); c.a = (const bf16_t*)(ws + WS_A);
    c.aoyc = (bf16_t*)(ap->out + OUT_Y); c.sinks = ap->in[I_SINKS];
    const float* zs = (const float*)(ws + WS_ZS); bf16_t* aoyc_s = (bf16_t*)(ws + WS_AOYC_S);
    const f32x2* rope = (const f32x2*)(ws + WS_ROPE);
    {
        const int c0 = 2 * tid;
        f32x2 w[31];
#pragma unroll
        for (int j = 0; j < 31; ++j) w[j] = *(const f32x2*)(ap->in[I_CDW] + (size_t)j * DM + c0);
        const f32x2 dwb = *(const f32x2*)(ap->in[I_CDWB] + c0), lg = *(const f32x2*)(ap->in[I_CLNG] + c0), lb = *(const f32x2*)(ap->in[I_CLNB] + c0);
        LAS float* red = (LAS float*)lds;
        LAS float* stat = (LAS float*)(lds + 2048);
        {
            constexpr int NCU = NBATCH * (SEQ / 16);
            unsigned av[46]; int par = 0;
            if (blk < NCU) { const int b = blk >> 9, t0 = (blk & 511) * 16;
#pragma unroll
                for (int r = 0; r < 46; ++r) { const int t = t0 - 30 + r; av[r] = (t >= 0) ? *(const unsigned*)(c.a + (size_t)(b * SEQ + t) * DM + c0) : 0u; } }
            for (int unit = blk; unit < NCU; unit += G) {
                const int b = unit >> 9, t0 = (unit & 511) * 16;
                LAS float* redp = red + par * 256; LAS float* statp = stat + par * 32;
                const int cid = unit * 512 + tid;
                f32x4 cc4 = {0.f, 0.f, 0.f, 0.f}; size_t cdst = 0; bool cok = false;
                if (cid < NS * 29 * 256) { const int sb = cid / (29 * 256), rem = cid - sb * (29 * 256); const int row = rem >> 8, ch = rem & 255; cok = true;
                    cdst = ((size_t)(sb * 30 + row) * 256 + ch) * 4; cc4 = __builtin_nontemporal_load((const f32x4*)(ap->in[I_SC] + ((size_t)(sb * 30 + row + 1) * 256 + ch) * 4)); }
                f32x2 y[16];
                {
                    f32x2 au[46];
#pragma unroll
                    for (int r = 0; r < 46; ++r) au[r] = (f32x2){bf_lo(av[r]), bf_hi(av[r])};
#pragma unroll
                    for (int i = 0; i < 16; ++i) y[i] = dwb;
#pragma unroll
                    for (int ig = 0; ig < 4; ++ig)
#pragma unroll
                        for (int j = 0; j < 31; ++j)
#pragma unroll
                            for (int i = 4 * ig; i < 4 * ig + 4; ++i) y[i] = pk_fma(au[i + j], w[j], y[i]);
                }
                if (unit + G < NCU) { const int nu = unit + G; const int nb = nu >> 9, nt0 = (nu & 511) * 16;
#pragma unroll
                    for (int r = 0; r < 46; ++r) { const int t = nt0 - 30 + r; av[r] = (t >= 0) ? *(const unsigned*)(c.a + (size_t)(nb * SEQ + t) * DM + c0) : 0u; } }
                {
                    float rv[32];
#pragma unroll
                    for (int i = 0; i < 16; ++i) { rv[i] = y[i][0] + y[i][1]; rv[16 + i] = y[i][0] * y[i][0] + y[i][1] * y[i][1]; }
#pragma unroll
                    for (int k = 0; k < 16; ++k) { const auto r = __builtin_amdgcn_permlane32_swap(__float_as_uint(rv[k]), __float_as_uint(rv[k + 16]), false, false); rv[k] = __uint_as_float(r[0]) + __uint_as_float(r[1]); }
#pragma unroll
                    for (int k = 0; k < 8; ++k) { const auto r = __builtin_amdgcn_permlane16_swap(__float_as_uint(rv[k]), __float_as_uint(rv[k + 8]), false, false); rv[k] = __uint_as_float(r[0]) + __uint_as_float(r[1]); }
                    const bool b3 = (lane & 8) != 0, b2 = (lane & 4) != 0, b1 = (lane & 2) != 0;
#pragma unroll
                    for (int k = 0; k < 4; ++k) { const float send = b3 ? rv[k] : rv[k + 4], keep = b3 ? rv[k + 4] : rv[k]; rv[k] = keep + dpp_all<0x140>(send); }
#pragma unroll
                    for (int k = 0; k < 2; ++k) { const float send = b2 ? rv[k] : rv[k + 2], keep = b2 ? rv[k + 2] : rv[k]; rv[k] = keep + dpp_all<0x141>(send); }
                    { const float send = b1 ? rv[0] : rv[1], keep = b1 ? rv[1] : rv[0]; rv[0] = keep + dpp_all<0x4E>(send); }
                    rv[0] += dpp_all<0xB1>(rv[0]);
                    if ((lane & 1) == 0) { const int v = lane >> 1; redp[(wave * 16 + (v & 15)) * 2 + (v >> 4)] = rv[0]; }
                }
                __syncthreads();
                if (tid < 16) { float s = 0.f, qq = 0.f;
#pragma unroll
                    for (int w8 = 0; w8 < 8; ++w8) { s += redp[(w8 * 16 + tid) * 2]; qq += redp[(w8 * 16 + tid) * 2 + 1]; }
                    const float mu = s * (1.f / DM); const float var = fmaxf(qq * (1.f / DM) - mu * mu, 0.f);
                    statp[tid * 2] = mu; statp[tid * 2 + 1] = rsqrtf(var + EPS); }
                __syncthreads();
#pragma unroll
                for (int i = 0; i < 16; ++i) { const float mu = statp[i * 2], rstd = statp[i * 2 + 1];
                    const float y0 = (y[i][0] - mu) * rstd * lg[0] + lb[0], y1 = (y[i][1] - mu) * rstd * lg[1] + lb[1];
                    *(unsigned*)(c.aoyc + (size_t)(b * SEQ + t0 + i) * 2048 + DM + c0) = cvt_pk_bf16(y0 * fsigmoid(y0), y1 * fsigmoid(y1)); }
                if (cok) *(f32x4*)(ap->out + OUT_NCS + cdst) = cc4;
                par ^= 1;
            }
            __syncthreads();
        }
        for (int b = blk; b < NS; b += G) {
            const float* st = ap->in[I_SC] + (size_t)b * 30 * DM + c0; float* nc = ap->out + OUT_NCS + (size_t)b * 30 * DM + c0;
            f32x2 acc = dwb;
#pragma unroll
            for (int j = 0; j < 30; ++j) { const f32x2 h = *(const f32x2*)(st + (size_t)j * DM); acc[0] += h[0] * w[j][0]; acc[1] += h[1] * w[j][1]; }
            const float* z = zs + (size_t)b * DIN; const float* bg = ap->in[I_BGLU];
            f32x2 an;
            an[0] = (z[1536 + c0] + bg[c0]) * fsigmoid(z[2560 + c0] + bg[DM + c0]); an[1] = (z[1536 + c0 + 1] + bg[c0 + 1]) * fsigmoid(z[2560 + c0 + 1] + bg[DM + c0 + 1]);
            *(f32x2*)(nc + (size_t)29 * DM) = an;
            acc[0] += an[0] * w[30][0]; acc[1] += an[1] * w[30][1];
            const float s = wave_sum(acc[0] + acc[1]), qq = wave_sum(acc[0] * acc[0] + acc[1] * acc[1]);
            if (lane == 0) { red[wave * 2] = s; red[wave * 2 + 1] = qq; }
            __syncthreads();
            float S = 0.f, Q = 0.f;
#pragma unroll
            for (int w8 = 0; w8 < 8; ++w8) { S += red[w8 * 2]; Q += red[w8 * 2 + 1]; }
            const float mu = S * (1.f / DM); const float rstd = rsqrtf(fmaxf(Q * (1.f / DM) - mu * mu, 0.f) + EPS);
            const float y0 = (acc[0] - mu) * rstd * lg[0] + lb[0], y1 = (acc[1] - mu) * rstd * lg[1] + lb[1];
            *(unsigned*)(aoyc_s + (size_t)b * 2048 + DM + c0) = cvt_pk_bf16(y0 * fsigmoid(y0), y1 * fsigmoid(y1));
            __syncthreads();
        }
    }
}

__device__ __forceinline__ void p2_attn(LAS unsigned char* lds, int blk, int G) {
    const ArgsP ap = kargs();
    int tid_ = threadIdx.x; asm volatile("" : "+v"(tid_));
    const int tid = tid_, wave = __builtin_amdgcn_readfirstlane(tid >> 6), lane = tid & 63;
    unsigned char* ws = ap->ws;
    P2Ctx c; c.q = (const bf16_t*)(ws + WS_Q); c.k = (const bf16_t*)(ws + WS_K); c.v = (const bf16_t*)(ws + WS_V); c.a = (const bf16_t*)(ws + WS_A);
    c.aoyc = (bf16_t*)(ap->out + OUT_Y); c.sinks = ap->in[I_SINKS];
    const float* zs = (const float*)(ws + WS_ZS); bf16_t* aoyc_s = (bf16_t*)(ws + WS_AOYC_S);
    const f32x2* rope = (const f32x2*)(ws + WS_ROPE);
    {
        constexpr int NU = NBATCH * (SEQ / 64) * 4; constexpr int ABUF = 55296;
        AttnPre P; int par = 0;
        if (blk < NU) attn_load(c, blk, P, tid, wave, lane);
        for (int unit = blk; unit < NU; unit += G) {
            LAS unsigned char* buf = lds + par * ABUF;
            attn_stage(P, buf, tid);
            bf16x8 qf[4];
#pragma unroll
            for (int ks = 0; ks < 4; ++ks) qf[ks] = P.q[ks];
            __syncthreads();
            if (unit + G < NU) attn_load(c, unit + G, P, tid, wave, lane);
            attn_compute(c, unit, qf, buf, wave, lane);
            par ^= 1;
        }
        __syncthreads();
    }
    {
        LAS float* Kf = (LAS float*)lds;
        LAS float* Vf = (LAS float*)(lds + 33280);
        LAS float* qs = (LAS float*)(lds + 66560);
        LAS float* scs = (LAS float*)(lds + 67584);
        float* nk = ap->out + OUT_NKS; float* nv = ap->out + OUT_NVS;
        for (int item = blk; item < NS * 4; item += G) {
            const int b = item >> 2, kvh = item & 3;
            const float* z = zs + (size_t)b * DIN;
            if (wave < 5) {
                const int d = lane; const bool isq = wave < 4;
                const float val = isq ? z[(kvh * 4 + wave) * 64 + d] : z[1024 + kvh * 64 + d];
                const float rs = rsqrtf(wave_sum(val * val) * (1.f / 64.f) + EPS);
                const float xn = val * rs * (isq ? ap->in[I_QN][d] : ap->in[I_KN][d]);
                const float other = __shfl_xor(xn, 32);
                const f32x2 cs = rope[(size_t)SEQ * 32 + (d & 31)];
                const float o = (d < 32) ? (xn * cs[0] - other * cs[1]) : (xn * cs[0] + other * cs[1]);
                if (isq) qs[wave * 64 + d] = o * QSCALE;
                else { Kf[127 * 65 + d] = o; nk[((size_t)(b * 128 + 127) * 4 + kvh) * 64 + d] = o; }
            } else if (wave == 5) {
                const float val = z[1280 + kvh * 64 + lane]; Vf[127 * 65 + lane] = val; nv[((size_t)(b * 128 + 127) * 4 + kvh) * 64 + lane] = val;
            }
            for (int idx = tid; idx < 127 * 16; idx += 512) {
                const int row = idx >> 4, c4 = idx & 15;
                const f32x4 kv4 = __builtin_nontemporal_load((const f32x4*)(ap->in[I_CK] + ((size_t)(b * 128 + row + 1) * 4 + kvh) * 64 + c4 * 4));
                const f32x4 vv4 = __builtin_nontemporal_load((const f32x4*)(ap->in[I_CV] + ((size_t)(b * 128 + row + 1) * 4 + kvh) * 64 + c4 * 4));
#pragma unroll
                for (int e = 0; e < 4; ++e) { Kf[row * 65 + c4 * 4 + e] = kv4[e]; Vf[row * 65 + c4 * 4 + e] = vv4[e]; }
                *(f32x4*)(nk + ((size_t)(b * 128 + row) * 4 + kvh) * 64 + c4 * 4) = kv4; *(f32x4*)(nv + ((size_t)(b * 128 + row) * 4 + kvh) * 64 + c4 * 4) = vv4;
            }
            __syncthreads();
            { const int j = tid >> 2, h = tid & 3; float s = 0.f;
#pragma unroll 16
              for (int d = 0; d < 64; ++d) s += Kf[j * 65 + d] * qs[h * 64 + d];
              scs[h * 128 + j] = s; }
            __syncthreads();
            if (wave < 4) { const float sink2 = ap->in[I_SINKS][kvh * 4 + wave] * LOG2E;
                const float v0 = scs[wave * 128 + lane], v1 = scs[wave * 128 + 64 + lane];
                const float mx = fmaxf(sink2, wave_max(fmaxf(v0, v1)));
                const float p0 = __builtin_amdgcn_exp2f(v0 - mx), p1 = __builtin_amdgcn_exp2f(v1 - mx);
                const float l = wave_sum(p0 + p1) + __builtin_amdgcn_exp2f(sink2 - mx); const float inv = 1.f / l;
                scs[wave * 128 + lane] = p0 * inv; scs[wave * 128 + 64 + lane] = p1 * inv; }
            __syncthreads();
            if (tid < 256) { const int h = tid >> 6, d = tid & 63; float o = 0.f;
#pragma unroll 16
                for (int j = 0; j < 128; ++j) o += scs[h * 128 + j] * Vf[j * 65 + d];
                aoyc_s[(size_t)b * 2048 + (kvh * 4 + h) * 64 + d] = (bf16_t)f2bf(o); }
            __syncthreads();
        }
    }
}


#define XB_TMO      128
#define XB_XCNT(j)  (256  + 64 * (j))
#define XB_XSUB(j)  (1280 + 64 * (j))
#define XB_XGEN(j)  (2304 + 64 * (j))
#define XB_TOP      3328
#define XB_TOPGEN   3392
#define XCD_BAR_WORDS 3456
#define XB_SPIN_CAP (1u << 18)
__device__ __forceinline__ unsigned xb_ld(unsigned* p)              { return __hip_atomic_load(p, __ATOMIC_RELAXED, __HIP_MEMORY_SCOPE_AGENT); }
__device__ __forceinline__ unsigned xb_add(unsigned* p, unsigned v) { return __hip_atomic_fetch_add(p, v, __ATOMIC_RELAXED, __HIP_MEMORY_SCOPE_AGENT); }
__device__ __forceinline__ unsigned xb_xcc_id() { return (unsigned)__builtin_amdgcn_s_getreg((3 << 11) | 20) & 0xFu; }
#define XB_SPIN(cond, bar) do { unsigned _sp = 0; while (cond) { __builtin_amdgcn_s_sleep(12); \
    if ((++_sp & 255u) == 0u) { if (xb_ld(&(bar)[XB_TMO])) break; if (_sp > XB_SPIN_CAP) { atomicAdd(&(bar)[XB_TMO], 1u); break; } } } } while (0)
struct XcdBarrier { unsigned* bar; unsigned x; volatile LAS unsigned* st; };
__device__ __forceinline__ XcdBarrier xcd_barrier_post(unsigned* bar, volatile LAS unsigned* st) {
    XcdBarrier b; b.bar = bar; b.x = xb_xcc_id(); b.st = st;
    if (threadIdx.x == 0) (void)xb_add(&bar[XB_XCNT(b.x)], 1u);
    return b;
}
__device__ __forceinline__ void xcd_barrier_complete(unsigned* bar, unsigned x, unsigned& nloc, unsigned& nx) {
    const unsigned G = gridDim.x * gridDim.y * gridDim.z;
    unsigned sum, cnt, mine, sp = 0u;
    for (;;) {
        sum = 0u; cnt = 0u; mine = 0u;
#pragma unroll
        for (unsigned j = 0; j < 16; ++j) { const unsigned c = xb_ld(&bar[XB_XCNT(j)]); sum += c; cnt += (c > 0u) ? 1u : 0u; mine = (j == x) ? c : mine; }
        if (sum == G) break;
        __builtin_amdgcn_s_sleep(1);
        if ((++sp & 255u) == 0u) { if (xb_ld(&bar[XB_TMO])) break; if (sp > XB_SPIN_CAP) { atomicAdd(&bar[XB_TMO], 1u); break; } }
    }
    nloc = mine > 0u ? mine : 1u; nx = cnt > 0u ? cnt : 1u;
}
__device__ __forceinline__ void xcd_barrier(const XcdBarrier& b) {
    asm volatile("s_waitcnt vmcnt(0)" ::: "memory");
    __syncthreads();
    if (threadIdx.x == 0) {
        unsigned* bar = b.bar;
        __builtin_amdgcn_s_waitcnt(0);
        unsigned nloc = b.st[0], nx = b.st[1];
        if (nloc == 0u) { xcd_barrier_complete(bar, b.x, nloc, nx); b.st[0] = nloc; b.st[1] = nx; }
        const unsigned old = xb_add(&bar[XB_XSUB(b.x)], 1u);
        const unsigned gen = old / nloc;
        if (old + 1u == (gen + 1u) * nloc) {
            __builtin_amdgcn_fence(__ATOMIC_RELEASE, "agent");
            asm volatile("s_waitcnt vmcnt(0)" ::: "memory");
            const unsigned og = xb_add(&bar[XB_TOP], 1u);
            const unsigned tg = og / nx;
            if (og + 1u == (tg + 1u) * nx) xb_add(&bar[XB_TOPGEN], 1u);
            else XB_SPIN(xb_ld(&bar[XB_TOPGEN]) == tg, bar);
            __builtin_amdgcn_fence(__ATOMIC_ACQUIRE, "agent");
            xb_add(&bar[XB_XGEN(b.x)], 1u);
            asm volatile("s_waitcnt vmcnt(0)" ::: "memory");
        } else {
            XB_SPIN(xb_ld(&bar[XB_XGEN(b.x)]) == gen, bar);
            __builtin_amdgcn_fence(__ATOMIC_ACQUIRE, "agent");
            asm volatile("s_waitcnt vmcnt(0)" ::: "memory");
        }
    }
    __syncthreads();
}
constexpr int CW_BAR = 4096;
constexpr size_t CTL_ZERO_BYTES = 65536 + 2 * 131072;
constexpr int MISC_OFF = RING_BYTES + 320;

__global__ void __launch_bounds__(512, 2) fwd(Args args) {
    extern __shared__ __attribute__((aligned(16))) unsigned char lds_raw[];
    LAS unsigned char* lds = (LAS unsigned char*)lds_raw;
    const int blk = blockIdx.x, G = gridDim.x;
#ifndef REPMASK
#define REPMASK 0
#endif
#define REP(k) for (int rep_ = 0; rep_ < 1 + ((REPMASK >> (k)) & 1); ++rep_)
#define IN(k) true
#define SEAM(k) do { XcdBarrier bar_; bar_.bar = (unsigned*)(kargs()->ws + WS_CTL) + CW_BAR; bar_.x = xb_xcc_id(); bar_.st = (volatile LAS unsigned*)(lds + MISC_OFF) + 8; xcd_barrier(bar_); } while (0)
    volatile LAS unsigned* MISC = (volatile LAS unsigned*)(lds + MISC_OFF);
    if (threadIdx.x < 32) MISC[threadIdx.x] = 0u;
    __syncthreads();
    (void)xcd_barrier_post((unsigned*)(kargs()->ws + WS_CTL) + CW_BAR, MISC + 8);
#define VB_ ((blk & 1) ? (blk >> 1) : ((G + 1) >> 1) + (blk >> 1))
#define mb_pre ((blk & 1) ? VB_ : (1 << 30))
#define mb_post ((blk & 1) ? (1 << 30) : VB_)
    if (IN(0)) REP(0) phase0<0>(lds, blk, G);
    SEAM(0);
    if (IN(1)) REP(1) {
        const ArgsP ap = kargs(); unsigned char* ws = ap->ws; bf16_t* U = (bf16_t*)(ws + WS_U);
        pg8::Gemm g{U, (const bf16_t*)(ws + WS_WIN), DM, DM, MP, DIN, DM}; pg8::StaticOrder S; S.init(MP, DIN, G, blk);
        EpiIn E; E.q = (bf16_t*)(ws + WS_Q); E.k = (bf16_t*)(ws + WS_K); E.v = (bf16_t*)(ws + WS_V); E.a = (bf16_t*)(ws + WS_A); E.gates = (unsigned short*)(ws + WS_RR);
        E.qn = ap->in[I_QN]; E.kn = ap->in[I_KN]; E.bglu = ap->in[I_BGLU]; E.rope = (const f32x2*)(ws + WS_ROPE);
        E.out_nk = ap->out + OUT_NK; E.out_nv = ap->out + OUT_NV; E.out_nc = ap->out + OUT_NC;
        MiniPart p{U + (size_t)MP * DM, DM, (const bf16_t*)(ws + WS_WIN), DM, DM}; MEpiZ ME{(float*)(ws + WS_ZS)};
        const int nj = blk < 4 * (DIN >> 5) ? (4 * (DIN >> 5) - blk + G - 1) / G : 0, npre = (nj * (blk & 3) + 1) / 3;
        mini_gemm<1>(lds, p, p, DIN, ME, blk, G, 0, npre);
        pg8::gemm_phase(lds, g, S, E);
        mini_gemm<1>(lds, p, p, DIN, ME, blk, G, npre, nj);
    }
    SEAM(1);
    if (IN(2)) REP(2) { if (blk & 1) p2_attn(lds, blk, G); p2_conv(lds, blk, G); if (!(blk & 1)) p2_attn(lds, blk, G); phase0<1>(lds, blk, G); __syncthreads(); }
    SEAM(2);
    if (IN(3)) REP(3) {
        const ArgsP ap = kargs(); unsigned char* ws = ap->ws; bf16_t* U = (bf16_t*)(ws + WS_U);
        pg8::Gemm g{(const bf16_t*)(ap->out + OUT_Y), (const bf16_t*)(ws + WS_WOC), 2048, 2048, MP, DM, 2048}; pg8::StaticOrder S; S.init(MP, DM, G, blk); S.rev = true;
        EpiMix E{(const unsigned short*)(ws + WS_RR), ap->in[I_BCO], (bf16_t*)(ws + WS_MIXED)};
        MiniPart p0{(const bf16_t*)(ws + WS_AOYC_S), 2048, (const bf16_t*)(ws + WS_WOC), 2048, DM};
        MiniPart p1{(const bf16_t*)(ws + WS_AOYC_S) + DM, 2048, (const bf16_t*)(ws + WS_WOC) + DM, 2048, DM};
        MEpiMix ME{(const float*)(ws + WS_ZS), ap->in[I_BCO], (bf16_t*)(ws + WS_MIX_S)};
        mini_gemm<2>(lds, p0, p1, DM, ME, mb_pre, G);
        pg8::gemm_phase(lds, g, S, E);
        mini_gemm<2>(lds, p0, p1, DM, ME, mb_post, G);
    }
    SEAM(3);
    if (IN(4)) REP(4) {
        const ArgsP ap = kargs(); unsigned char* ws = ap->ws; bf16_t* U = (bf16_t*)(ws + WS_U);
        pg8::Gemm g{(const bf16_t*)(ws + WS_MIXED), (const bf16_t*)(ws + WS_WOUT), DM, DM, MP, DM, DM}; pg8::StaticOrder S; S.init(MP, DM, G, blk);
        EpiResB<true> E{U, (float*)(ws + WS_RSS1), (const float*)(ws + WS_XINV), ap->in[I_LN1]};
        MiniPart p{(const bf16_t*)(ws + WS_MIX_S), DM, (const bf16_t*)(ws + WS_WOUT), DM, DM};
        MEpiRes ME{ap->in[I_XS], ap->out + OUT_YS, (bf16_t*)(ws + WS_HB_S), (float*)(ws + WS_RSS1_S)};
        mini_gemm<1>(lds, p, p, DM, ME, mb_pre, G);
        pg8::gemm_phase(lds, g, S, E);
        mini_gemm<1>(lds, p, p, DM, ME, mb_post, G);
    }
    SEAM(4);
    if (IN(5)) REP(5) {
        const ArgsP ap = kargs(); unsigned char* ws = ap->ws; bf16_t* U = (bf16_t*)(ws + WS_U);
        pg8::Gemm g{U, (const bf16_t*)(ws + WS_WFF1), DM, DM, MP, DFF, DM}; pg8::StaticOrder S; S.init(MP, DFF, G, blk);
        EpiFF1 E{(const float*)(ws + WS_RSS1), (bf16_t*)(ws + WS_F)};
        MiniPart p{(const bf16_t*)(ws + WS_HB_S), DM, (const bf16_t*)(ws + WS_WFF1), DM, DM};
        MEpiFF1 ME{(const float*)(ws + WS_RSS1_S), (bf16_t*)(ws + WS_F_S)};
        const int nj = blk < 4 * (DFF >> 5) ? (4 * (DFF >> 5) - blk + G - 1) / G : 0, npre = (nj * (blk & 3) + 1) / 3;
        mini_gemm<1>(lds, p, p, DFF, ME, blk, G, 0, npre);
        pg8::gemm_phase(lds, g, S, E);
        mini_gemm<1>(lds, p, p, DFF, ME, blk, G, npre, nj);
    }
    SEAM(5);
    if (IN(6)) {
        const ArgsP ap = kargs(); unsigned char* ws = ap->ws; bf16_t* U = (bf16_t*)(ws + WS_U);
        pg8::Gemm g{(const bf16_t*)(ws + WS_F), (const bf16_t*)(ws + WS_WFF2), DFF, DFF, MP, DM, DFF}; pg8::StaticOrder S; S.init(MP, DM, G, blk);
        EpiResB<false> E{U, (float*)(ws + WS_RSS2), nullptr, nullptr};
        MiniPart p{(const bf16_t*)(ws + WS_F_S), DFF, (const bf16_t*)(ws + WS_WFF2), DFF, DFF};
        MEpiRes ME{ap->out + OUT_YS, ap->out + OUT_YS, (bf16_t*)(ws + WS_H2B_S), (float*)(ws + WS_RSS2_S)};
        mini_gemm<1>(lds, p, p, DM, ME, mb_pre, G);
        pg8::gemm_phase(lds, g, S, E);
        mini_gemm<1>(lds, p, p, DM, ME, mb_post, G);
    }
    SEAM(6);
    if (IN(7)) {
        const ArgsP ap = kargs(); unsigned char* ws = ap->ws; bf16_t* U = (bf16_t*)(ws + WS_U);
        MiniPart p0{(const bf16_t*)(ws + WS_PB) + (size_t)MP * DM, DM, (const bf16_t*)(ws + WS_WPLE), DM, DPLE};
        MiniPart p1{(const bf16_t*)(ws + WS_H2B_S), DM, (const bf16_t*)(ws + WS_WPG), DM, DM};
        MEpiGate ME{(const float*)(ws + WS_RSS2_S), ap->out + OUT_YS};
        mini_gemm<2>(lds, p0, p1, DM, ME, mb_pre, G);
        { pg8::Gemm g{U, (const bf16_t*)(ws + WS_WPG), DM, DM, MP, DM, DM}, g1{(const bf16_t*)(ws + WS_PB), (const bf16_t*)(ws + WS_WPLE), DM, DM, MP, DM, DPLE};
          pg8::StaticOrder S; S.init(MP, DM, G, blk);
          EpiGate2 E{(const float*)(ws + WS_RSS2), U, ap->out + OUT_Y};
          pg8::gemm_phase<EpiGate2, true>(lds, g, S, E, g1); }
        mini_gemm<2>(lds, p0, p1, DM, ME, mb_post, G);
    }
#undef IN
#undef SEAM
#undef mb_pre
#undef mb_post
#undef VB_
}

extern "C" void kernel_launch(void* const* d_in, const int* in_sizes, int n_in, void* d_out, int out_size, void* d_ws, size_t ws_size, hipStream_t stream) {
    static int grid = 0;
    if (grid == 0) {
        if (n_in != 27 || (size_t)out_size != OUT_END || ws_size < WS_END) { fprintf(stderr, "kernel_launch: unexpected shapes: n_in %d out %d ws %zu (need %zu)\n", n_in, out_size, ws_size, (size_t)WS_END); grid = -1; return; }
        int dev = 0, cus = 0;
        if (hipGetDevice(&dev) != hipSuccess || hipDeviceGetAttribute(&cus, hipDeviceAttributeMultiprocessorCount, dev) != hipSuccess) { grid = -1; return; }
        if (hipFuncSetAttribute((const void*)fwd, hipFuncAttributeMaxDynamicSharedMemorySize, LDS_BYTES) != hipSuccess) { fprintf(stderr, "kernel_launch: hipFuncSetAttribute failed\n"); grid = -1; return; }
        int per_cu = 0;
        if (hipOccupancyMaxActiveBlocksPerMultiprocessor(&per_cu, (const void*)fwd, 512, LDS_BYTES) != hipSuccess || per_cu < 1) { fprintf(stderr, "kernel_launch: occupancy query says %d blocks per CU\n", per_cu); grid = -1; return; }
        grid = cus;
    }
    if (grid < 0) return;
    Args a{};
    for (int i = 0; i < 27; ++i) a.in[i] = (const float*)d_in[i];
    a.out = (float*)d_out; a.ws = (unsigned char*)d_ws;
    a.ph_lo = 0; a.ph_hi = 8;
    if (hipMemsetAsync((char*)d_ws + WS_CTL, 0, CTL_ZERO_BYTES, stream) != hipSuccess) { fprintf(stderr, "kernel_launch: memset failed\n"); return; }
    hipLaunchKernelGGL(fwd, dim3(grid), dim3(512), LDS_BYTES, stream, a);
    hipError_t e = hipPeekAtLastError();
    if (e != hipSuccess) fprintf(stderr, "kernel_launch: launch failed: %s (grid %d)\n", hipGetErrorString(e), grid);
}
```
